# Optimizing an MI355X kernel written in HIP

```python
import math
import jax, jax.numpy as jnp
from jax import lax
import numpy as np

D_MODEL = 1024
BATCH = 8
SEQ = 2048
DEPTH = 2
DEC_BATCH = 128
DEC_SEQ = 1
PAST_LEN = 16384
PAGE_SIZE = 128

H_A = 4
DK_A = 128
DV_A = 128
H_B = 4
DK_B = 128
DV_B = 128
CONV_W = 4
CHUNK_A = 64
CHUNK_B = 16
D_FF = -(-8 * D_MODEL // (3 * 256)) * 256
QK_A = H_A * DK_A
V_A = H_A * DV_A
K_B = H_B * DK_B
V_B = H_B * DV_B
CONV_DIM = 2 * QK_A + V_A
MIX_WIDTH = V_A + V_B
IN_SPLITS = (QK_A, QK_A, V_A, V_A, H_A, H_A, K_B, K_B, V_B, V_B)
IN_DIM = sum(IN_SPLITS)
EPS = 1e-6

kernel_name = 'hybrid_gdn_hgrn2_adaln_decode_step'


def _rmsnorm(x, w):
    x32 = x.astype(jnp.float32)
    y = x32 * lax.rsqrt(jnp.mean(x32 * x32, axis=-1, keepdims=True) + EPS)
    return (y * w.astype(jnp.float32)).astype(x.dtype)


def _l2norm(x):
    return x * lax.rsqrt(jnp.sum(x * x, axis=-1, keepdims=True) + EPS)


def _pad_time(t, pad):
    if pad == 0:
        return t
    widths = [(0, 0)] * t.ndim
    widths[1] = (0, pad)
    return jnp.pad(t, widths)


def _to_chunks(t, C):
    Bn, Lp, H = t.shape[:3]
    t = t.reshape((Bn, Lp // C, C, H) + t.shape[3:])
    perm = (1, 0, 3, 2) + tuple(range(4, t.ndim))
    return jnp.transpose(t, perm)


def _from_chunks(o, L):
    n, Bn, H, C, V = o.shape
    return jnp.transpose(o, (1, 0, 3, 2, 4)).reshape(Bn, n * C, H, V)[:, :L]


def _causal_conv(u, buf, w):
    L = u.shape[1]
    full = jnp.concatenate([buf.astype(u.dtype), u], axis=1)
    out = full[:, 0:L] * w[0]
    for j in range(1, CONV_W):
        out = out + full[:, j:j + L] * w[j]
    return jax.nn.silu(out), full[:, full.shape[1] - (CONV_W - 1):]


def _gated_delta_chunked(q, k, v, g, beta, S0):
    Bn, L, H, DK = q.shape
    C = min(CHUNK_A, L)
    n = -(-L // C)
    pad = n * C - L
    q, k, v, g, beta = [_pad_time(t, pad) for t in (q, k, v, g, beta)]
    q = _to_chunks(q * DK ** -0.5, C)
    k = _to_chunks(k, C)
    v = _to_chunks(v, C)
    g = _to_chunks(g, C)
    beta = _to_chunks(beta, C)
    G = jnp.cumsum(g, axis=-1)
    eye = jnp.eye(C, dtype=jnp.float32)
    tril = jnp.tril(jnp.ones((C, C), dtype=bool))
    dec = jnp.exp(jnp.where(tril, G[..., :, None] - G[..., None, :], -jnp.inf))
    kb = k * beta[..., None]
    A = jnp.einsum('nbhik,nbhjk->nbhij', kb, k) * dec * (1.0 - eye)
    T = lax.linalg.triangular_solve(eye + A, jnp.broadcast_to(eye, A.shape), left_side=True, lower=True)
    u = jnp.einsum('nbhij,nbhjv->nbhiv', T, v * beta[..., None])
    w = jnp.einsum('nbhij,nbhjk->nbhik', T, kb * jnp.exp(G)[..., None])
    qk = jnp.einsum('nbhik,nbhjk->nbhij', q, k) * dec
    qd = q * jnp.exp(G)[..., None]
    kd = k * jnp.exp(G[..., -1:] - G)[..., None]
    gl = jnp.exp(G[..., -1])

    def step(S, xs):
        u_c, w_c, qk_c, qd_c, kd_c, gl_c = xs
        v_new = u_c - jnp.einsum('bhck,bhkv->bhcv', w_c, S)
        o = jnp.einsum('bhck,bhkv->bhcv', qd_c, S) + jnp.einsum('bhij,bhjv->bhiv', qk_c, v_new)
        S = S * gl_c[..., None, None] + jnp.einsum('bhck,bhcv->bhkv', kd_c, v_new)
        return S, o

    S, o = lax.scan(step, S0, (u, w, qk, qd, kd, gl))
    return _from_chunks(o, L), S


def _hgrn2_chunked(q, k, v, logf, S0):
    Bn, L, H, DK = q.shape
    C = min(CHUNK_B, L)
    n = -(-L // C)
    pad = n * C - L
    q, k, v, logf = [_to_chunks(_pad_time(t, pad), C) for t in (q, k, v, logf)]
    G = jnp.cumsum(logf, axis=-2)
    tril = jnp.tril(jnp.ones((C, C), dtype=bool))

    def step(S, xs):
        qc, kc, vc, Gc = xs
        diff = Gc[:, :, :, None, :] - Gc[:, :, None, :, :]
        dec = jnp.exp(jnp.where(tril[:, :, None], diff, -jnp.inf))
        A = jnp.sum(qc[:, :, :, None, :] * kc[:, :, None, :, :] * dec, axis=-1)
        o = jnp.einsum('bhik,bhkv->bhiv', qc * jnp.exp(Gc), S) + jnp.einsum('bhij,bhjv->bhiv', A, vc)
        Gl = Gc[:, :, -1:, :]
        S = S * jnp.exp(Gl[:, :, 0, :])[..., None] + jnp.einsum('bhck,bhcv->bhkv', kc * jnp.exp(Gl - Gc), vc)
        return S, o

    S, o = lax.scan(step, S0, (q, k, v, G))
    return _from_chunks(o, L), S


def _layer(x, c, S_a, buf, S_b, lb, w_ada, b_ada, norm1, w_in, conv_w, a_log, dt_bias,
           norm_a, norm_b, w_out, norm2, w_gate, w_up, w_down):
    f32 = jnp.float32
    Bn, L, _ = x.shape
    mods = (jax.nn.silu(c) @ w_ada + b_ada)[:, None, :]
    shift1, scale1, gate1, shift2, scale2, gate2 = jnp.split(mods, 6, axis=-1)
    h = _rmsnorm(x, norm1) * (1 + scale1) + shift1
    proj = h @ w_in
    cuts = np.cumsum(IN_SPLITS)[:-1].tolist()
    qa, ka, va, za, aa, ba, qb, fb, ib, ob = jnp.split(proj, cuts, axis=-1)
    qkv, new_buf = _causal_conv(jnp.concatenate([qa, ka, va], axis=-1), buf, conv_w)
    qkv = qkv.astype(f32)
    qa_, ka_, va_ = jnp.split(qkv, [QK_A, 2 * QK_A], axis=-1)
    qh = _l2norm(qa_.reshape(Bn, L, H_A, DK_A))
    kh = _l2norm(ka_.reshape(Bn, L, H_A, DK_A))
    vh = va_.reshape(Bn, L, H_A, DV_A)
    beta = jax.nn.sigmoid(ba.astype(f32))
    g = -jnp.exp(a_log.astype(f32)) * jax.nn.softplus(aa.astype(f32) + dt_bias.astype(f32))
    o_a, S_a_new = _gated_delta_chunked(qh, kh, vh, g, beta, S_a.astype(f32))
    o_a = _rmsnorm(o_a, norm_a) * jax.nn.silu(za.astype(f32).reshape(Bn, L, H_A, DV_A))
    lbh = lb.astype(f32).reshape(H_B, DK_B)
    f = lbh + (1.0 - lbh) * jax.nn.sigmoid(fb.astype(f32).reshape(Bn, L, H_B, DK_B))
    qbh = jax.nn.silu(qb.astype(f32).reshape(Bn, L, H_B, DK_B))
    ibh = ib.astype(f32).reshape(Bn, L, H_B, DV_B)
    o_b, S_b_new = _hgrn2_chunked(qbh, 1.0 - f, ibh, jnp.log(f), S_b.astype(f32))
    o_b = _rmsnorm(o_b, norm_b) * jax.nn.sigmoid(ob.astype(f32).reshape(Bn, L, H_B, DV_B))
    mix = jnp.concatenate([o_a.reshape(Bn, L, V_A), o_b.reshape(Bn, L, V_B)], axis=-1).astype(x.dtype) @ w_out
    x = x + gate1 * mix
    h = _rmsnorm(x, norm2) * (1 + scale2) + shift2
    x = x + gate2 * ((jax.nn.silu(h @ w_gate) * (h @ w_up)) @ w_down)
    return x, S_a_new, new_buf, S_b_new


def _trunk(x, c, S_a, buf, S_b, lb_all, stacked, norm_f):
    new_a, new_buf, new_b = [], [], []
    for l in range(DEPTH):
        x, sa, bf, sb = _layer(x, c, S_a[l], buf[l], S_b[l], lb_all[l], *[p[l] for p in stacked])
        new_a.append(sa)
        new_buf.append(bf)
        new_b.append(sb)
    return _rmsnorm(x, norm_f), jnp.stack(new_a), jnp.stack(new_buf), jnp.stack(new_b)


def setup_inputs(seed: int = 0) -> dict:
    key = jax.random.key(seed)
    ks = jax.random.split(key, 24)
    f32 = jnp.float32

    def nrm(k, shape, scale):
        return jax.random.normal(k, shape, f32) * scale

    dt = jnp.exp(jax.random.uniform(ks[13], (DEPTH, H_A), f32, math.log(1e-3), math.log(1e-1)))
    return {
        'x_prompt': nrm(ks[0], (BATCH, SEQ, D_MODEL), 1.0),
        'x_sample': nrm(ks[1], (DEC_BATCH, DEC_SEQ, D_MODEL), 1.0),
        'c_prompt': nrm(ks[2], (BATCH, D_MODEL), 1.0),
        'c_sample': nrm(ks[3], (DEC_BATCH, D_MODEL), 1.0),
        'state_delta': nrm(ks[4], (DEPTH, DEC_BATCH, H_A, DK_A, DV_A), 0.3),
        'state_conv': nrm(ks[5], (DEPTH, DEC_BATCH, CONV_W - 1, CONV_DIM), 1.0),
        'state_hgrn': nrm(ks[6], (DEPTH, DEC_BATCH, H_B, DK_B, DV_B), 0.5),
        'w_ada': nrm(ks[7], (DEPTH, D_MODEL, 6 * D_MODEL), 0.5 * D_MODEL ** -0.5),
        'b_ada': nrm(ks[8], (DEPTH, 6 * D_MODEL), 0.01),
        'norm1': 1.0 + nrm(ks[9], (DEPTH, D_MODEL), 0.01),
        'w_in': nrm(ks[10], (DEPTH, D_MODEL, IN_DIM), D_MODEL ** -0.5),
        'conv_w': nrm(ks[11], (DEPTH, CONV_W, CONV_DIM), CONV_W ** -0.5),
        'a_log': jnp.log(jax.random.uniform(ks[12], (DEPTH, H_A), f32, 1.0, 16.0)),
        'dt_bias': dt + jnp.log(-jnp.expm1(-dt)),
        'norm_a': 1.0 + nrm(ks[14], (DEPTH, DV_A), 0.01),
        'norm_b': 1.0 + nrm(ks[15], (DEPTH, DV_B), 0.01),
        'lb_logits': nrm(ks[16], (DEPTH, K_B), 1.0),
        'w_out': nrm(ks[17], (DEPTH, MIX_WIDTH, D_MODEL), MIX_WIDTH ** -0.5),
        'norm2': 1.0 + nrm(ks[18], (DEPTH, D_MODEL), 0.01),
        'w_gate': nrm(ks[19], (DEPTH, D_MODEL, D_FF), D_MODEL ** -0.5),
        'w_up': nrm(ks[20], (DEPTH, D_MODEL, D_FF), D_MODEL ** -0.5),
        'w_down': nrm(ks[21], (DEPTH, D_FF, D_MODEL), D_FF ** -0.5),
        'norm_f': 1.0 + nrm(ks[22], (D_MODEL,), 0.01),
    }


def reference(x_prompt, x_sample, c_prompt, c_sample, state_delta, state_conv, state_hgrn,
              w_ada, b_ada, norm1, w_in, conv_w, a_log, dt_bias, norm_a, norm_b, lb_logits,
              w_out, norm2, w_gate, w_up, w_down, norm_f):
    f32 = jnp.float32
    sm = jax.nn.softmax(lb_logits.astype(f32), axis=0)
    lb_all = jnp.cumsum(sm, axis=0) - sm[0:1]
    stacked = (w_ada, b_ada, norm1, w_in, conv_w, a_log, dt_bias, norm_a, norm_b,
               w_out, norm2, w_gate, w_up, w_down)
    bp = x_prompt.shape[0]
    sa0 = jnp.zeros((DEPTH, bp, H_A, DK_A, DV_A), f32)
    buf0 = jnp.zeros((DEPTH, bp, CONV_W - 1, CONV_DIM), x_prompt.dtype)
    sb0 = jnp.zeros((DEPTH, bp, H_B, DK_B, DV_B), f32)
    y_prompt, delta_p, conv_p, hgrn_p = _trunk(x_prompt, c_prompt, sa0, buf0, sb0, lb_all, stacked, norm_f)
    y_sample, delta_s, conv_s, hgrn_s = _trunk(x_sample, c_sample, state_delta, state_conv, state_hgrn,
                                               lb_all, stacked, norm_f)
    return (y_prompt, y_sample, delta_p, conv_p, hgrn_p, delta_s, conv_s, hgrn_s)
```

```cpp
#include <hip/hip_runtime.h>
#include <hip/hip_cooperative_groups.h>
namespace cg = cooperative_groups;

#define LAS __attribute__((address_space(3)))
#define DI __device__ __forceinline__
typedef unsigned short bf16_t;
typedef short bf16x8 __attribute__((ext_vector_type(8)));
typedef short s16x4 __attribute__((ext_vector_type(4)));
typedef float f32x4 __attribute__((ext_vector_type(4)));
typedef float f32x2 __attribute__((ext_vector_type(2)));
typedef float f32x16 __attribute__((ext_vector_type(16)));
typedef unsigned u32x4 __attribute__((ext_vector_type(4)));
typedef unsigned u32x2 __attribute__((ext_vector_type(2)));
typedef __bf16 bf16x2_t __attribute__((ext_vector_type(2)));

constexpr int MP = 16384, MS = 128, MT = MP + MS, MPAD = 16640;
constexpr int DM = 1024, SEQ = 2048, NB = 8, NH = 4, DH = 128;
constexpr int INW = 4104, NIN = 4096, DFF = 2816, NGU = 5632, CONVD = 1536;
constexpr int NMOD = 6 * DM, MODROWS = NB + MS;
constexpr int NCH = 32, CH = 64;
constexpr float EPS = 1e-6f;
constexpr int PC_QA = 0, PC_KA = 512, PC_VA = 1024, PC_ZA = 1536, PC_QB = 2048, PC_FB = 2560, PC_IB = 3072, PC_OB = 3584;

constexpr size_t SZ_WIN = (size_t)NIN * DM * 2, SZ_WOUT = (size_t)DM * DM * 2, SZ_WGU = (size_t)NGU * DM * 2, SZ_WDN = (size_t)DM * DFF * 2;
constexpr size_t WS_WIN = 0;
constexpr size_t WS_WOUT = WS_WIN + 2 * SZ_WIN;
constexpr size_t WS_WGU = WS_WOUT + 2 * SZ_WOUT;
constexpr size_t WS_WDN = WS_WGU + 2 * SZ_WGU;
constexpr size_t WS_MODS = WS_WDN + 2 * SZ_WDN;
constexpr size_t WS_AB = WS_MODS + (size_t)2 * MODROWS * NMOD * 4;
constexpr size_t WS_LB = WS_AB + (size_t)MT * 8 * 4;
constexpr size_t WS_H = WS_LB + 4096;
constexpr size_t WS_PROJ = WS_H + (size_t)MPAD * DM * 2;
constexpr size_t DPACK_STRIDE = 77568, HPACK_STRIDE = 33280;
constexpr size_t WS_DPACK = WS_PROJ + (size_t)MPAD * NIN * 2;
constexpr size_t WS_HPACK = WS_DPACK + (size_t)1024 * DPACK_STRIDE;
constexpr size_t WS_BAR = WS_HPACK + (size_t)1024 * HPACK_STRIDE;
constexpr size_t WS_END = WS_BAR + 16384;
static_assert(WS_END <= (size_t)358000000, "workspace map");
static_assert(WS_WOUT % 256 == 0 && WS_WGU % 256 == 0 && WS_WDN % 256 == 0 && WS_MODS % 256 == 0 && WS_AB % 256 == 0 && WS_LB % 256 == 0 && WS_H % 256 == 0 && WS_PROJ % 256 == 0 && WS_DPACK % 256 == 0 && WS_HPACK % 256 == 0, "alignment");
constexpr int DP_NW = 0, DP_QD = 16896, DP_KDT = 33792, DP_UT = 51200, DP_QK = 68608, DP_GL = 77312, DP_BYTES = 77328;
constexpr int R128 = 264, R64 = 136;
constexpr size_t OUT_Y = 0;
constexpr size_t OUT_DP = (size_t)MT * DM;
constexpr size_t OUT_CP = OUT_DP + (size_t)2 * NB * NH * DH * DH;
constexpr size_t OUT_HP = OUT_CP + (size_t)2 * NB * 3 * CONVD;
constexpr size_t OUT_DS = OUT_HP + (size_t)2 * NB * NH * DH * DH;
constexpr size_t OUT_CS = OUT_DS + (size_t)2 * MS * NH * DH * DH;
constexpr size_t OUT_HS = OUT_CS + (size_t)2 * MS * 3 * CONVD;
constexpr size_t OUT_END = OUT_HS + (size_t)2 * MS * NH * DH * DH;

constexpr int LDS_BYTES = 147456;
constexpr int LDS_MISC = LDS_BYTES - 64;

DI unsigned pk2(float lo, float hi) { f32x2 v = {lo, hi}; bf16x2_t b = __builtin_convertvector(v, bf16x2_t); return __builtin_bit_cast(unsigned, b); }
DI unsigned short f2bf(float f) { return (unsigned short)(pk2(f, 0.f) & 0xffffu); }
DI float bf2f(unsigned short b) { return __uint_as_float(((unsigned)b) << 16); }
DI float bflo(unsigned w) { return __uint_as_float(w << 16); }
DI float bfhi(unsigned w) { return __uint_as_float(w & 0xffff0000u); }
DI float sigmoidf_(float x) { return __builtin_amdgcn_rcpf(1.f + __expf(-x)); }
DI float siluf_(float x) { return x * __builtin_amdgcn_rcpf(1.f + __expf(-x)); }
template <int CTRL> DI float dpp_(float x) { return __builtin_bit_cast(float, __builtin_amdgcn_mov_dpp(__builtin_bit_cast(int, x), CTRL, 0xf, 0xf, true)); }
DI float wave_sum(float v) {
    v += dpp_<0xB1>(v); v += dpp_<0x4E>(v); v += dpp_<0x141>(v); v += dpp_<0x128>(v);
    auto s = __builtin_amdgcn_permlane16_swap(__float_as_uint(v), __float_as_uint(v), false, false);
    v = __uint_as_float(s[0]) + __uint_as_float(s[1]);
    auto t = __builtin_amdgcn_permlane32_swap(__float_as_uint(v), __float_as_uint(v), false, false);
    return __uint_as_float(t[0]) + __uint_as_float(t[1]);
}
DI int modrow_of(int row) { return row < MP ? (row >> 11) : (NB + row - MP); }

struct Params {
    const float *x_prompt, *x_sample, *c_prompt, *c_sample, *state_delta, *state_conv, *state_hgrn;
    const float *w_ada, *b_ada, *norm1, *w_in, *conv_w, *a_log, *dt_bias, *norm_a, *norm_b, *lb_logits;
    const float *w_out, *norm2, *w_gate, *w_up, *w_down, *norm_f;
    float* out; unsigned char* ws;
    int ph_lo, ph_hi;
};
#define N_LAUNCH_MODE 1
namespace pg8 {
#define PG8_LAS __attribute__((address_space(3)))
typedef unsigned short bf16_t;
typedef short bf16x8 __attribute__((ext_vector_type(8)));
typedef float f32x4 __attribute__((ext_vector_type(4)));
typedef unsigned u32x4 __attribute__((ext_vector_type(4)));
constexpr int BM = 256, BK = 64, HALF = 128, HTB = HALF * BK * 2  , STAGE_BYTES = 8 * HTB, NXCD = 8, WGM = 8;

__host__ __device__ __forceinline__ int lds_byte(int r, int c) { const int st = (r >> 4) * 2 + (c >> 5), rr = r & 15, cc = c & 31, ob = rr * 64 + cc * 2; return st * 1024 + (ob ^ (((ob >> 9) & 1) << 5)); }
__host__ __device__ __forceinline__ void stage_rc(int b, int& R, int& C) { const int st = b / 1024, sb = b % 1024, swz = sb ^ (((sb >> 9) & 1) << 5); R = (st >> 1) * 16 + swz / 64; C = (st & 1) * 32 + (swz % 64) / 2; }
__host__ __device__ __forceinline__ int perm32(int rho) { const int n = rho >> 4, i = rho & 15; return 8 * (i >> 2) + 4 * n + (i & 3); }

struct Unit { int pm, pn; };
struct Gemm { const bf16_t* A; const bf16_t* Bt; int M, N, K; };

struct StaticOrder {
    int nM, nN, nwg, G, c;
    __host__ __device__ void init(int M, int N, int G_, int c_) { nM = M / BM; nN = N / BM; nwg = nM * nN; G = G_; c = c_; }
    __host__ __device__ bool next(int i, Unit& u) const {
        const long L = (long)i * G + c; if (L >= nwg) return false;
        int wgid = (int)L; { const int q = nwg / NXCD, r = nwg % NXCD, xcd = wgid % NXCD, off = wgid / NXCD; wgid = (xcd < r ? xcd * (q + 1) : r * (q + 1) + (xcd - r) * q) + off; }
        const int nig = WGM * nN, gid = wgid / nig, fm = gid * WGM, gsz = (nM - fm) < WGM ? (nM - fm) : WGM;
        u.pm = fm + ((wgid % nig) % gsz); u.pn = (wgid % nig) / gsz; return true;
    }
    __device__ __forceinline__ void a_ready(const Unit&) const {}
    __device__ __forceinline__ void done(const Unit&) const {}
};
__device__ __forceinline__ unsigned cvt_pk_bf16(float lo, float hi) { unsigned r; asm volatile("v_cvt_pk_bf16_f32 %0, %1, %2" : "=v"(r) : "v"(lo), "v"(hi)); return r; }
typedef float f32x2 __attribute__((ext_vector_type(2)));
struct EpiProj {
    static constexpr bool PERM = true, AFTER_DRAIN = false;
    bf16_t* O; int ldc;
    __device__ __forceinline__ void operator()(const f32x4 (&acc)[2][2][4][2], const Unit& u, int wr, int wc, int fr, int fq) const {
        const int row0 = u.pm * BM + wr * 64 + fr; const int col0 = u.pn * BM + wc * 32 + 8 * fq;
        const int kind = (u.pn == 6 || u.pn == 7) ? 1 : (u.pn >= 14 ? 2 : 0);
#pragma unroll
        for (int ai = 0; ai < 2; ++ai)
#pragma unroll
            for (int m = 0; m < 4; ++m) { bf16_t* rowp = O + (size_t)(row0 + ai * HALF + m * 16) * ldc + col0;
#pragma unroll
                for (int bj = 0; bj < 2; ++bj) { f32x4 v0 = acc[ai][bj][m][0], v1 = acc[ai][bj][m][1];
                    if (kind) {
#pragma unroll
                        for (int j = 0; j < 4; ++j) { const float s0 = __builtin_amdgcn_rcpf(1.f + __expf(-v0[j])), s1 = __builtin_amdgcn_rcpf(1.f + __expf(-v1[j])); v0[j] = kind == 1 ? v0[j] * s0 : s0; v1[j] = kind == 1 ? v1[j] * s1 : s1; } }
                    u32x4 w; w.x = ::pk2(v0[0], v0[1]); w.y = ::pk2(v0[2], v0[3]); w.z = ::pk2(v1[0], v1[1]); w.w = ::pk2(v1[2], v1[3]);
                    *(u32x4*)(rowp + bj * HALF) = w; } }
    }
};
struct EpiSwiGLU {
    static constexpr bool PERM = true, AFTER_DRAIN = false;
    bf16_t* O; int ldc;
    __device__ __forceinline__ void operator()(const f32x4 (&acc)[2][2][4][2], const Unit& u, int wr, int wc, int fr, int fq) const {
        const int row0 = u.pm * BM + wr * 64 + fr; const int col0 = u.pn * HALF + wc * 32 + 8 * fq;
#pragma unroll
        for (int ai = 0; ai < 2; ++ai)
#pragma unroll
            for (int m = 0; m < 4; ++m) { bf16_t* rowp = O + (size_t)(row0 + ai * HALF + m * 16) * ldc + col0;
                float r[8];
#pragma unroll
                for (int n = 0; n < 2; ++n)
#pragma unroll
                    for (int j = 0; j < 4; ++j) { const float g = acc[ai][0][m][n][j], up = acc[ai][1][m][n][j]; r[4 * n + j] = g * __builtin_amdgcn_rcpf(1.f + __expf(-g)) * up; }
                u32x4 w; w.x = ::pk2(r[0], r[1]); w.y = ::pk2(r[2], r[3]); w.z = ::pk2(r[4], r[5]); w.w = ::pk2(r[6], r[7]);
                *(u32x4*)rowp = w; }
    }
};
template <bool IN_F32> struct EpiRes {
    static constexpr bool PERM = false, AFTER_DRAIN = false;
    const void* xin; bf16_t* XB; const float* gate;
    __device__ __forceinline__ f32x4 ldx(size_t off) const {
        if (IN_F32) return *(const f32x4*)((const float*)xin + off);
        const u32x2 w = *(const u32x2*)((const bf16_t*)xin + off); return (f32x4){::bflo(w.x), ::bfhi(w.x), ::bflo(w.y), ::bfhi(w.y)};
    }
    __device__ __forceinline__ void operator()(const f32x4 (&acc)[2][2][4][2], const Unit& u, int wr, int wc, int fr, int fq) const {
        const int row0 = u.pm * BM + wr * 64 + fr, col0 = u.pn * BM + wc * 32 + 4 * fq;
        const float* gp = gate + (size_t)((u.pm * BM) >> 11) * ::NMOD + col0;
        f32x4 gv[2][2];
#pragma unroll
        for (int bj = 0; bj < 2; ++bj)
#pragma unroll
            for (int n = 0; n < 2; ++n) gv[bj][n] = *(const f32x4*)(gp + bj * HALF + n * 16);
        f32x4 xv[2][2][2];
#pragma unroll
        for (int bj = 0; bj < 2; ++bj)
#pragma unroll
            for (int n = 0; n < 2; ++n) xv[0][bj][n] = ldx((size_t)row0 * ::DM + col0 + bj * HALF + n * 16);
#pragma unroll
        for (int g = 0; g < 8; ++g) { const int ai = g >> 2, m = g & 3; const int row = row0 + ai * HALF + m * 16;
            if (g + 1 < 8) { const int nrow = row0 + ((g + 1) >> 2) * HALF + ((g + 1) & 3) * 16;
#pragma unroll
                for (int bj = 0; bj < 2; ++bj)
#pragma unroll
                    for (int n = 0; n < 2; ++n) xv[(g + 1) & 1][bj][n] = ldx((size_t)nrow * ::DM + col0 + bj * HALF + n * 16); }
            bf16_t* xo = XB + (size_t)row * ::DM + col0;
#pragma unroll
            for (int bj = 0; bj < 2; ++bj)
#pragma unroll
                for (int n = 0; n < 2; ++n) { const f32x4 r = xv[g & 1][bj][n] + gv[bj][n] * acc[ai][bj][m][n]; u32x2 o; o.x = ::pk2(r.x, r.y); o.y = ::pk2(r.z, r.w); *(u32x2*)(xo + bj * HALF + n * 16) = o; }
        }
    }
};
template <class Epi, class Sched, bool ALIGN_EPI = false, bool SP2 = false>
__device__ __forceinline__ void gemm_phase(PG8_LAS unsigned char* lds, const Gemm g, const Sched& S, const Epi& E) {
    int tid_ = threadIdx.x; asm volatile("" : "+v"(tid_));
    const int tid = tid_, wid = __builtin_amdgcn_readfirstlane(tid >> 6), lane = tid & 63, wr = wid >> 2, wc = wid & 3, fr = lane & 15, fq = lane >> 4;
    const int K = g.K, nt = K / BK;
    unsigned voffA[2], voffB[2];
#pragma unroll
    for (int i = 0; i < 2; ++i) { int R, C; stage_rc(tid * 16 + i * 8192, R, C); const int Rb = Epi::PERM ? ((R & ~31) + perm32(R & 31)) : R;
        voffA[i] = (unsigned)(R * K + C) * 2u; voffB[i] = (unsigned)(Rb * K + C) * 2u; }
    const size_t kstep = (size_t)(BK * 2);
    const size_t hstep = (size_t)HALF * K * 2;
    const size_t tstep = 2 * hstep;
    const unsigned ldsw = (unsigned)wid * 1024u;
    const int aoff = lds_byte(wr * 64 + fr, fq * 8), boff = lds_byte(wc * 32 + fr, fq * 8);
#define PG8_SA(b, h) (((b) * 2 + (h)) * HTB)
#define PG8_SB(b, h) ((4 + (b) * 2 + (h)) * HTB)
#define PG8_STAGE(bufoff, gbase, voff) do { _Pragma("unroll") for (int _i = 0; _i < 2; ++_i) \
        __builtin_amdgcn_global_load_lds((const unsigned*)((const char*)(gbase) + (voff)[_i]), (PG8_LAS unsigned*)(lds + (bufoff) + ldsw + _i * 8192), 16, 0, 0); } while (0)
#define PG8_LDA(dst, b, h) do { _Pragma("unroll") for (int m = 0; m < 4; ++m) _Pragma("unroll") for (int k = 0; k < 2; ++k) dst[m][k] = *(const PG8_LAS bf16x8*)(lds + PG8_SA(b, h) + aoff + m * 2048 + k * 1024); } while (0)
#define PG8_LDB(dst, b, h) do { _Pragma("unroll") for (int n = 0; n < 2; ++n) _Pragma("unroll") for (int k = 0; k < 2; ++k) dst[n][k] = *(const PG8_LAS bf16x8*)(lds + PG8_SB(b, h) + boff + n * 2048 + k * 1024); } while (0)
#define PG8_MMA(ai, bj, At, Bt) do { __builtin_amdgcn_s_setprio(1); _Pragma("unroll") for (int m = 0; m < 4; ++m) _Pragma("unroll") for (int n = 0; n < 2; ++n) _Pragma("unroll") for (int k = 0; k < 2; ++k) \
        acc[ai][bj][m][n] = __builtin_amdgcn_mfma_f32_16x16x32_bf16(Bt[n][k], At[m][k], acc[ai][bj][m][n], 0, 0, 0); __builtin_amdgcn_s_setprio(0); } while (0)
#define PG8_WAIT_V(n) asm volatile("s_waitcnt vmcnt(" #n ")" ::: "memory")
#define PG8_WAIT_L(n) asm volatile("s_waitcnt lgkmcnt(" #n ")" ::: "memory")
#define PG8_BAR __builtin_amdgcn_s_barrier()
#define PG8_SCHED __builtin_amdgcn_sched_barrier(0)
    Unit cur, nxt; int ui = 0;
    if (!S.next(0, cur)) return;
    f32x4 acc[2][2][4][2];
#pragma unroll
    for (int a = 0; a < 2; ++a)
#pragma unroll
        for (int b = 0; b < 2; ++b)
#pragma unroll
            for (int m = 0; m < 4; ++m)
#pragma unroll
                for (int n = 0; n < 2; ++n) acc[a][b][m][n] = (f32x4){0.f, 0.f, 0.f, 0.f};
    bf16x8 At[4][2], B0[2][2], B1[2][2];
    const char* cA = (const char*)g.A + (size_t)cur.pm * tstep; const char* cB = (const char*)g.Bt + (size_t)cur.pn * tstep;
    S.a_ready(cur);
    if constexpr (SP2) {
        PG8_STAGE(PG8_SB(0, 0), cB, voffB); PG8_STAGE(PG8_SB(0, 1), cB + hstep, voffB); PG8_STAGE(PG8_SA(0, 0), cA, voffA); PG8_STAGE(PG8_SA(0, 1), cA + hstep, voffA);
        if (wr == 1) PG8_BAR;
        PG8_WAIT_V(2); PG8_BAR;
        PG8_STAGE(PG8_SB(1, 0), cB + kstep, voffB); PG8_STAGE(PG8_SA(1, 0), cA + kstep, voffA); PG8_STAGE(PG8_SB(1, 1), cB + hstep + kstep, voffB);
        PG8_WAIT_V(6); PG8_BAR;
    } else {
        PG8_STAGE(PG8_SB(0, 0), cB, voffB); PG8_STAGE(PG8_SA(0, 0), cA, voffA); PG8_STAGE(PG8_SB(0, 1), cB + hstep, voffB); PG8_STAGE(PG8_SA(0, 1), cA + hstep, voffA);
        if (wr == 1) PG8_BAR;
        PG8_WAIT_V(4); PG8_BAR;
        PG8_STAGE(PG8_SB(1, 0), cB + kstep, voffB); PG8_STAGE(PG8_SA(1, 0), cA + kstep, voffA); PG8_STAGE(PG8_SB(1, 1), cB + hstep + kstep, voffB);
        PG8_WAIT_V(6); PG8_BAR;
    }
    for (;;) {
        const bool has_next = S.next(ui + 1, nxt);
        const char* nA = has_next ? (const char*)g.A + (size_t)nxt.pm * tstep : cA; const char* nB = has_next ? (const char*)g.Bt + (size_t)nxt.pn * tstep : cB;
        for (int t = 0; t < nt; t += 2) {
            const bool last = (t == nt - 2);
            const char* a1 = cA + (size_t)(t + 1) * kstep;
            const char* a2 = last ? nA : cA + (size_t)(t + 2) * kstep; const char* b2 = last ? nB : cB + (size_t)(t + 2) * kstep;
            const char* a3 = a2 + kstep; const char* b3 = b2 + kstep;
            if (last && has_next) S.a_ready(nxt);
            if constexpr (SP2) {
            PG8_LDB(B0, 0, 0); PG8_LDB(B1, 0, 1); PG8_SCHED; PG8_LDA(At, 0, 0); PG8_STAGE(PG8_SA(1, 1), a1 + hstep, voffA);
            PG8_WAIT_V(8); PG8_WAIT_L(0); PG8_BAR; PG8_MMA(0, 0, At, B0); PG8_MMA(0, 1, At, B1); PG8_BAR; PG8_SCHED;
            PG8_LDA(At, 0, 1); PG8_STAGE(PG8_SB(0, 0), b2, voffB); PG8_STAGE(PG8_SB(0, 1), b2 + hstep, voffB); PG8_STAGE(PG8_SA(0, 0), a2, voffA);
            PG8_WAIT_V(8); PG8_WAIT_L(0); PG8_BAR; PG8_MMA(1, 0, At, B0); PG8_MMA(1, 1, At, B1); PG8_BAR; PG8_SCHED;
            PG8_LDB(B0, 1, 0); PG8_LDB(B1, 1, 1); PG8_SCHED; PG8_LDA(At, 1, 0); PG8_STAGE(PG8_SA(0, 1), a2 + hstep, voffA);
            PG8_WAIT_V(8); PG8_WAIT_L(0); PG8_BAR; PG8_MMA(0, 0, At, B0); PG8_MMA(0, 1, At, B1); PG8_BAR; PG8_SCHED;
            PG8_LDA(At, 1, 1); PG8_STAGE(PG8_SB(1, 0), b3, voffB); PG8_STAGE(PG8_SB(1, 1), b3 + hstep, voffB); PG8_STAGE(PG8_SA(1, 0), a3, voffA);
            PG8_WAIT_V(8); PG8_WAIT_L(0); PG8_BAR; PG8_MMA(1, 0, At, B0); PG8_MMA(1, 1, At, B1); PG8_BAR; PG8_SCHED;
            } else {
            PG8_LDB(B0, 0, 0); PG8_SCHED; PG8_LDA(At, 0, 0); PG8_STAGE(PG8_SA(1, 1), a1 + hstep, voffA);
            PG8_WAIT_L(8); PG8_BAR; PG8_WAIT_L(0); PG8_MMA(0, 0, At, B0); PG8_BAR; PG8_SCHED;
            PG8_LDB(B1, 0, 1); PG8_STAGE(PG8_SB(0, 0), b2, voffB);
            PG8_BAR; PG8_WAIT_L(0); PG8_MMA(0, 1, At, B1); PG8_BAR;
            PG8_LDA(At, 0, 1); PG8_STAGE(PG8_SA(0, 0), a2, voffA);
            PG8_BAR; PG8_WAIT_L(0); PG8_MMA(1, 0, At, B0); PG8_BAR; PG8_SCHED;
            PG8_STAGE(PG8_SB(0, 1), b2 + hstep, voffB);
            PG8_WAIT_V(6); PG8_BAR; PG8_MMA(1, 1, At, B1); PG8_BAR;
            PG8_LDB(B0, 1, 0); PG8_SCHED; PG8_LDA(At, 1, 0); PG8_STAGE(PG8_SA(0, 1), a2 + hstep, voffA);
            PG8_WAIT_L(8); PG8_BAR; PG8_WAIT_L(0); PG8_MMA(0, 0, At, B0); PG8_BAR; PG8_SCHED;
            PG8_LDB(B1, 1, 1); PG8_STAGE(PG8_SB(1, 0), b3, voffB);
            PG8_BAR; PG8_WAIT_L(0); PG8_MMA(0, 1, At, B1); PG8_BAR;
            PG8_LDA(At, 1, 1); PG8_STAGE(PG8_SA(1, 0), a3, voffA);
            PG8_BAR; PG8_WAIT_L(0); PG8_MMA(1, 0, At, B0); PG8_BAR; PG8_SCHED;
            PG8_STAGE(PG8_SB(1, 1), b3 + hstep, voffB);
            PG8_WAIT_V(6); PG8_BAR; PG8_MMA(1, 1, At, B1); PG8_BAR;
            }
        }
        if constexpr (ALIGN_EPI) { if (wr == 0) PG8_BAR; }
        if constexpr (!Epi::AFTER_DRAIN) { E(acc, cur, wr, wc, fr, fq); S.done(cur); }
        if (!has_next) break;
#pragma unroll
        for (int a = 0; a < 2; ++a)
#pragma unroll
            for (int b = 0; b < 2; ++b)
#pragma unroll
                for (int m = 0; m < 4; ++m)
#pragma unroll
                    for (int n = 0; n < 2; ++n) acc[a][b][m][n] = (f32x4){0.f, 0.f, 0.f, 0.f};
        cur = nxt; cA = nA; cB = nB; ++ui;
        if constexpr (ALIGN_EPI) { if (wr == 1) PG8_BAR; }
    }
    PG8_WAIT_V(0);
    if constexpr (!ALIGN_EPI) { if (wr == 0) PG8_BAR; }
    PG8_BAR;
    if constexpr (Epi::AFTER_DRAIN) { E.fused(acc, cur, wr, wc, fr, fq, lds, wid, lane); S.done(cur); }
#undef PG8_SA
#undef PG8_SB
#undef PG8_STAGE
#undef PG8_LDA
#undef PG8_LDB
#undef PG8_MMA
#undef PG8_WAIT_V
#undef PG8_WAIT_L
#undef PG8_BAR
#undef PG8_SCHED
}
}


#define XB_TMO      128
#define XB_XCNT(j)  (256  + 64 * (j))
#define XB_XSUB(j)  (1280 + 64 * (j))
#define XB_XGEN(j)  (2304 + 64 * (j))
#define XB_TOP      3328
#define XB_TOPGEN   3392
#define XCD_BAR_WORDS 3456
#define XB_SPIN_CAP (1u << 18)

__device__ __forceinline__ unsigned xb_ld(unsigned* p)              { return __hip_atomic_load(p, __ATOMIC_RELAXED, __HIP_MEMORY_SCOPE_AGENT); }
__device__ __forceinline__ unsigned xb_add(unsigned* p, unsigned v) { return __hip_atomic_fetch_add(p, v, __ATOMIC_RELAXED, __HIP_MEMORY_SCOPE_AGENT); }
__device__ __forceinline__ unsigned xb_xcc_id() { return (unsigned)__builtin_amdgcn_s_getreg((3 << 11) | 20) & 0xFu; }
#define XB_SPIN(cond, bar) do { unsigned _sp = 0; while (cond) { __builtin_amdgcn_s_sleep(1); \
    if ((++_sp & 255u) == 0u) { if (xb_ld(&(bar)[XB_TMO])) break; if (_sp > XB_SPIN_CAP) { atomicAdd(&(bar)[XB_TMO], 1u); break; } } } } while (0)

struct XcdBarrier {
    unsigned* bar; unsigned x;
    volatile LAS unsigned* st;
};

__device__ __forceinline__ XcdBarrier xcd_barrier_post(unsigned* bar, volatile LAS unsigned* st) {
    XcdBarrier b; b.bar = bar; b.x = xb_xcc_id(); b.st = st;
    if (threadIdx.x == 0) (void)xb_add(&bar[XB_XCNT(b.x)], 1u);
    return b;
}
__device__ __forceinline__ void xcd_barrier_complete(unsigned* bar, unsigned x, unsigned& nloc, unsigned& nx) {
    const unsigned G = gridDim.x * gridDim.y * gridDim.z;
    unsigned sum, cnt, mine, sp = 0u;
    for (;;) {
        sum = 0u; cnt = 0u; mine = 0u;
#pragma unroll
        for (unsigned j = 0; j < 16; ++j) { const unsigned c = xb_ld(&bar[XB_XCNT(j)]); sum += c; cnt += (c > 0u) ? 1u : 0u; mine = (j == x) ? c : mine; }
        if (sum == G) break;
        __builtin_amdgcn_s_sleep(1);
        if ((++sp & 255u) == 0u) { if (xb_ld(&bar[XB_TMO])) break; if (sp > XB_SPIN_CAP) { atomicAdd(&bar[XB_TMO], 1u); break; } }
    }
    nloc = mine > 0u ? mine : 1u; nx = cnt > 0u ? cnt : 1u;
}

__device__ __forceinline__ void xcd_barrier(const XcdBarrier& b) {
    asm volatile("s_waitcnt vmcnt(0)" ::: "memory");
    __syncthreads();
    if (threadIdx.x == 0) {
        unsigned* bar = b.bar;
        __builtin_amdgcn_s_waitcnt(0);
        unsigned nloc = b.st[0], nx = b.st[1];
        if (nloc == 0u) { xcd_barrier_complete(bar, b.x, nloc, nx); b.st[0] = nloc; b.st[1] = nx; }
        const unsigned old = xb_add(&bar[XB_XSUB(b.x)], 1u);
        const unsigned gen = old / nloc;
        if (old + 1u == (gen + 1u) * nloc) {
            __builtin_amdgcn_fence(__ATOMIC_RELEASE, "agent");
            asm volatile("s_waitcnt vmcnt(0)" ::: "memory");
            const unsigned og = xb_add(&bar[XB_TOP], 1u);
            const unsigned tg = og / nx;
            if (og + 1u == (tg + 1u) * nx) xb_add(&bar[XB_TOPGEN], 1u);
            else XB_SPIN(xb_ld(&bar[XB_TOPGEN]) == tg, bar);
            __builtin_amdgcn_fence(__ATOMIC_ACQUIRE, "agent");
            xb_add(&bar[XB_XGEN(b.x)], 1u);
            asm volatile("s_waitcnt vmcnt(0)" ::: "memory");
        } else {
            XB_SPIN(xb_ld(&bar[XB_XGEN(b.x)]) == gen, bar);
            __builtin_amdgcn_fence(__ATOMIC_ACQUIRE, "agent");
            asm volatile("s_waitcnt vmcnt(0)" ::: "memory");
        }
    }
    __syncthreads();
}
DI void transpose_item(const float* W, int ldw, int srccol0, int k0, bf16_t* WT, int ldk, int dstrow0, LAS float* scr, int lane) {
#pragma unroll
    for (int i = 0; i < 32; ++i) { const int kk = 2 * i + (lane >> 5); scr[kk * 33 + (lane & 31)] = W[(size_t)(k0 + kk) * ldw + srccol0 + (lane & 31)]; }
    asm volatile("s_waitcnt lgkmcnt(0)" ::: "memory");
    const int c = lane & 7;
#pragma unroll
    for (int j = 0; j < 4; ++j) { const int n = (lane >> 3) + 8 * j; const LAS float* s = scr + (8 * c) * 33 + n;
        u32x4 o; o.x = pk2(s[0 * 33], s[1 * 33]); o.y = pk2(s[2 * 33], s[3 * 33]); o.z = pk2(s[4 * 33], s[5 * 33]); o.w = pk2(s[6 * 33], s[7 * 33]);
        *(u32x4*)(WT + (size_t)(dstrow0 + n) * ldk + k0 + 8 * c) = o; }
    asm volatile("s_waitcnt lgkmcnt(0)" ::: "memory");
}

DI void prologue_work(const Params& P, LAS unsigned char* lds, int wk, int nwork, int it_lo, int it_hi, int slab_lo, int slab_hi, bool do_lb) {
    int tid_ = threadIdx.x; asm volatile("" : "+v"(tid_));
    const int tid = tid_, lane = tid & 63, wave = tid >> 6, G = nwork, bid = wk;
    unsigned char* ws = P.ws;
    {
        LAS float* scr = (LAS float*)(lds + wave * 16384);
        constexpr int I_IN = 16 * 128, I_OUT = 16 * 32, I_G = 16 * 88, I_D = 44 * 32, I_L = I_IN + I_OUT + 2 * I_G + I_D;
        const int gw = bid * 8 + wave, NGW = G * 8;
        for (int it = it_lo + gw; it < it_hi; it += NGW) {
            const int l = it / I_L; int r = it % I_L;
            if (r < I_IN) { const int kb = r / 128, nb = r % 128, n0 = 32 * nb;
                transpose_item(P.w_in + (size_t)l * DM * INW, INW, n0 < 2048 ? n0 : n0 + 8, 64 * kb, (bf16_t*)(ws + WS_WIN + l * SZ_WIN), DM, n0, scr, lane); continue; }
            r -= I_IN;
            if (r < I_OUT) { const int kb = r / 32, nb = r % 32;
                transpose_item(P.w_out + (size_t)l * DM * DM, DM, 32 * nb, 64 * kb, (bf16_t*)(ws + WS_WOUT + l * SZ_WOUT), DM, 32 * nb, scr, lane); continue; }
            r -= I_OUT;
            if (r < 2 * I_G) { const int up = r / I_G; r %= I_G; const int kb = r / 88, nb = r % 88, n0 = 32 * nb;
                transpose_item((up ? P.w_up : P.w_gate) + (size_t)l * DM * DFF, DFF, n0, 64 * kb, (bf16_t*)(ws + WS_WGU + l * SZ_WGU), DM, 256 * (n0 >> 7) + 128 * up + (n0 & 127), scr, lane); continue; }
            r -= 2 * I_G;
            { const int kb = r / 32, nb = r % 32;
                transpose_item(P.w_down + (size_t)l * DFF * DM, DM, 32 * nb, 64 * kb, (bf16_t*)(ws + WS_WDN + l * SZ_WDN), DFF, 32 * nb, scr, lane); }
        }
    }
    if (do_lb && bid == 0) {
        float* lb = (float*)(ws + WS_LB);
        for (int j = tid; j < 512; j += 512) { const float a = P.lb_logits[j], b = P.lb_logits[512 + j]; const float m = fmaxf(a, b); const float ea = expf(a - m), eb = expf(b - m);
            lb[j] = 0.f; lb[512 + j] = eb / (ea + eb); }
    }
    __syncthreads();
    {
        constexpr int M_AHI = 0, M_ALO = 144 * 272, M_BHI = 2 * 144 * 272, M_BLO = M_BHI + 48 * 272;
        float* mods = (float*)(ws + WS_MODS);
        const int fr = lane & 15, fq = lane >> 4;
        for (int e = tid; e < 8 * 136 / 2; e += 512) { ((LAS unsigned*)(lds + M_AHI + 136 * 272))[e] = 0u; ((LAS unsigned*)(lds + M_ALO + 136 * 272))[e] = 0u; }
        for (int slab = slab_lo + bid; slab < slab_hi; slab += G) {
            const int l = slab >> 7, n0 = (slab & 127) * 48;
            f32x4 acc[4];
#pragma unroll
            for (int i = 0; i < 4; ++i) acc[i] = (f32x4){0.f, 0.f, 0.f, 0.f};
            float wreg[12]; f32x4 creg[9];
#define MODS_LOAD(kc_) do { int tidl = tid; asm volatile("" : "+v"(tidl));     \
                _Pragma("unroll") for (int i = 0; i < 12; ++i) { const int e = tidl + 512 * i; const int k = e / 48, c = e % 48; wreg[i] = P.w_ada[((size_t)l * DM + (kc_) * 128 + k) * NMOD + n0 + c]; } \
                _Pragma("unroll") for (int i = 0; i < 9; ++i) { const int e = tidl + 512 * i; if (i < 8 || e < MODROWS * 32) { const int row = e >> 5, k4 = e & 31; \
                    creg[i] = *(const f32x4*)((row < NB ? P.c_prompt + (size_t)row * DM : P.c_sample + (size_t)(row - NB) * DM) + (kc_) * 128 + 4 * k4); } } } while (0)
            MODS_LOAD(0);
            for (int kc = 0; kc < 8; ++kc) {
                __syncthreads();
#pragma unroll
                for (int i = 0; i < 12; ++i) { const int e = tid + 512 * i; const int k = e / 48, c = e % 48; const float w = wreg[i];
                    const unsigned short hi = f2bf(w); *(LAS unsigned short*)(lds + M_BHI + c * 272 + 2 * k) = hi; *(LAS unsigned short*)(lds + M_BLO + c * 272 + 2 * k) = f2bf(w - bf2f(hi)); }
#pragma unroll
                for (int i = 0; i < 9; ++i) { const int e = tid + 512 * i; if (i < 8 || e < MODROWS * 32) { const int row = e >> 5, k4 = e & 31;
                    f32x4 v = creg[i]; v.x = siluf_(v.x); v.y = siluf_(v.y); v.z = siluf_(v.z); v.w = siluf_(v.w);
                    u32x2 h; h.x = pk2(v.x, v.y); h.y = pk2(v.z, v.w);
                    u32x2 lo; lo.x = pk2(v.x - bflo(h.x), v.y - bfhi(h.x)); lo.y = pk2(v.z - bflo(h.y), v.w - bfhi(h.y));
                    *(LAS u32x2*)(lds + M_AHI + row * 272 + 8 * k4) = h; *(LAS u32x2*)(lds + M_ALO + row * 272 + 8 * k4) = lo; } }
                __syncthreads();
                if (kc + 1 < 8) MODS_LOAD(kc + 1);
#pragma unroll
                for (int i = 0; i < 4; ++i) { const int t = wave + 8 * i;
                    if (t < 27) { const int rt = t / 3, ct = t % 3;
#pragma unroll
                        for (int ks = 0; ks < 4; ++ks) {
                            const bf16x8 ah = *(const LAS bf16x8*)(lds + M_AHI + (16 * rt + fr) * 272 + (32 * ks + 8 * fq) * 2), al = *(const LAS bf16x8*)(lds + M_ALO + (16 * rt + fr) * 272 + (32 * ks + 8 * fq) * 2);
                            const bf16x8 bh = *(const LAS bf16x8*)(lds + M_BHI + (16 * ct + fr) * 272 + (32 * ks + 8 * fq) * 2), bl = *(const LAS bf16x8*)(lds + M_BLO + (16 * ct + fr) * 272 + (32 * ks + 8 * fq) * 2);
                            acc[i] = __builtin_amdgcn_mfma_f32_16x16x32_bf16(ah, bh, acc[i], 0, 0, 0);
                            acc[i] = __builtin_amdgcn_mfma_f32_16x16x32_bf16(ah, bl, acc[i], 0, 0, 0);
                            acc[i] = __builtin_amdgcn_mfma_f32_16x16x32_bf16(al, bh, acc[i], 0, 0, 0);
                        } } }
            }
#pragma unroll
            for (int i = 0; i < 4; ++i) { const int t = wave + 8 * i;
                if (t < 27) { const int rt = t / 3, ct = t % 3; const int col = n0 + 16 * ct + fr; const float bb = P.b_ada[(size_t)l * NMOD + col];
#pragma unroll
                    for (int jj = 0; jj < 4; ++jj) { const int row = 16 * rt + 4 * fq + jj; if (row < MODROWS) mods[((size_t)l * MODROWS + row) * NMOD + col] = acc[i][jj] + bb; } } }
        }
#undef MODS_LOAD
    }
}

constexpr int P0_I_IN = 16 * 128, P0_I_ALL = 2 * (16 * 128 + 16 * 32 + 2 * 16 * 88 + 44 * 32);
DI void phase0(const Params& P, LAS unsigned char* lds) { prologue_work(P, lds, blockIdx.x, gridDim.x, 0, P0_I_IN, 0, 256, true); }
DI void phase0_rest(const Params& P, LAS unsigned char* lds, int wk, int nwork) { __syncthreads(); prologue_work(P, lds, wk, nwork, P0_I_IN, P0_I_ALL, 256, 256, false); }

template <int WHICH>
DI void phase_norm(const Params& P, int l, LAS unsigned char* lds) {
    int tid_ = threadIdx.x; asm volatile("" : "+v"(tid_));
    const int tid = tid_, lane = tid & 63, wave = tid >> 6, G = gridDim.x, bid = blockIdx.x;
    unsigned char* ws = P.ws;
    LAS float* wab = (LAS float*)lds;
    if (WHICH == 1) {
#pragma unroll
        for (int i = 0; i < 16; ++i) { const int e = tid + 512 * i; wab[e] = P.w_in[((size_t)l * DM + (e >> 3)) * INW + 2048 + (e & 7)]; }
        __syncthreads();
    }
    const bf16_t* XB = (const bf16_t*)P.out;
    const float* mods = (const float*)(ws + WS_MODS) + (size_t)l * MODROWS * NMOD;
    const float* nw = (WHICH == 1 ? P.norm1 : P.norm2) + (size_t)l * DM;
    constexpr int SHIFT = WHICH == 1 ? 0 : 3 * DM, SCALE = WHICH == 1 ? DM : 4 * DM;
    bf16_t* H = (bf16_t*)(ws + WS_H);
    float* AB = (float*)(ws + WS_AB);
#define NORM_LOADROW(row_, dst_) do { if (WHICH == 1 && l == 0) { const float* xr_ = (row_) < MP ? P.x_prompt + (size_t)(row_) * DM : P.x_sample + (size_t)((row_) - MP) * DM; \
            _Pragma("unroll") for (int j = 0; j < 4; ++j) dst_[j] = *(const f32x4*)(xr_ + 4 * (lane + 64 * j)); } \
        else { const bf16_t* xr_ = XB + (size_t)(row_) * DM; \
            _Pragma("unroll") for (int j = 0; j < 4; ++j) { const u32x2 w_ = *(const u32x2*)(xr_ + 4 * (lane + 64 * j)); dst_[j] = (f32x4){bflo(w_.x), bfhi(w_.x), bflo(w_.y), bfhi(w_.y)}; } } } while (0)
    f32x4 vn[3][4];
#pragma unroll
    for (int q = 0; q < 3; ++q) { const int rowq = bid * 8 + wave + q * G * 8; if (rowq < MT) NORM_LOADROW(rowq, vn[q]); }
    for (int row = bid * 8 + wave; row < MT; row += G * 8) {
        const float* mr = mods + (size_t)modrow_of(row) * NMOD;
        f32x4 v[4]; float ss = 0.f;
#pragma unroll
        for (int j = 0; j < 4; ++j) { v[j] = vn[0][j]; vn[0][j] = vn[1][j]; vn[1][j] = vn[2][j]; }
        { const int nrow = row + 3 * G * 8; if (nrow < MT) NORM_LOADROW(nrow, vn[2]); }
#pragma unroll
        for (int j = 0; j < 4; ++j) ss += v[j].x * v[j].x + v[j].y * v[j].y + v[j].z * v[j].z + v[j].w * v[j].w;
        const float rs = rsqrtf(wave_sum(ss) * (1.f / DM) + EPS);
        float ab[8];
#pragma unroll
        for (int e = 0; e < 8; ++e) ab[e] = 0.f;
#pragma unroll
        for (int j = 0; j < 4; ++j) { const int col = 4 * (lane + 64 * j);
            const f32x4 w4 = *(const f32x4*)(nw + col), sc = *(const f32x4*)(mr + SCALE + col), sh = *(const f32x4*)(mr + SHIFT + col);
            f32x4 h = v[j] * rs * w4 * (sc + 1.f) + sh;
            u32x2 o; o.x = pk2(h.x, h.y); o.y = pk2(h.z, h.w);
            *(u32x2*)(H + (size_t)row * DM + col) = o;
            if (WHICH == 1) {
#pragma unroll
                for (int e = 0; e < 4; ++e) { const f32x4 a = *(const LAS f32x4*)(wab + (col + e) * 8), b = *(const LAS f32x4*)(wab + (col + e) * 8 + 4); const float hv = h[e];
                    ab[0] += hv * a.x; ab[1] += hv * a.y; ab[2] += hv * a.z; ab[3] += hv * a.w; ab[4] += hv * b.x; ab[5] += hv * b.y; ab[6] += hv * b.z; ab[7] += hv * b.w; }
            }
        }
        if (WHICH == 1) {
#pragma unroll
            for (int e = 0; e < 8; ++e) ab[e] = wave_sum(ab[e]);
            if (lane == 0) { *(f32x4*)(AB + (size_t)row * 8) = (f32x4){ab[0], ab[1], ab[2], ab[3]}; *(f32x4*)(AB + (size_t)row * 8 + 4) = (f32x4){ab[4], ab[5], ab[6], ab[7]}; }
        }
    }
}

constexpr int FIN_ROWS = 9;
DI void phase_final(const Params& P, const XcdBarrier& bar) {
    int tid_ = threadIdx.x; asm volatile("" : "+v"(tid_));
    const int tid = tid_, lane = tid & 63, wave = tid >> 6, G = gridDim.x, bid = blockIdx.x;
    const bf16_t* XB = (const bf16_t*)P.out; float* Y = P.out;
    u32x2 xr[FIN_ROWS][4];
#pragma unroll
    for (int k = 0; k < FIN_ROWS; ++k) { const int row = bid * 8 + wave + k * G * 8;
        if (row < MT) {
#pragma unroll
            for (int j = 0; j < 4; ++j) xr[k][j] = *(const u32x2*)(XB + (size_t)row * DM + 4 * (lane + 64 * j)); } }
    xcd_barrier(bar);
#pragma unroll
    for (int k = 0; k < FIN_ROWS; ++k) { const int row = bid * 8 + wave + k * G * 8;
        if (row < MT) {
            f32x4 v[4]; float ss = 0.f;
#pragma unroll
            for (int j = 0; j < 4; ++j) { v[j] = (f32x4){bflo(xr[k][j].x), bfhi(xr[k][j].x), bflo(xr[k][j].y), bfhi(xr[k][j].y)}; ss += v[j].x * v[j].x + v[j].y * v[j].y + v[j].z * v[j].z + v[j].w * v[j].w; }
            const float rs = rsqrtf(wave_sum(ss) * (1.f / DM) + EPS);
#pragma unroll
            for (int j = 0; j < 4; ++j) { const int col = 4 * (lane + 64 * j); const f32x4 w4 = *(const f32x4*)(P.norm_f + col); *(f32x4*)(Y + (size_t)row * DM + col) = v[j] * rs * w4; } } }
}
#define MFMA16(a, b, c) __builtin_amdgcn_mfma_f32_16x16x32_bf16((a), (b), (c), 0, 0, 0)
#define MFMA32(a, b, c) __builtin_amdgcn_mfma_f32_32x32x16_bf16((a), (b), (c), 0, 0, 0)
DI bf16x8 lds_frag16(const LAS unsigned char* p) { return *(const LAS bf16x8*)p; }

constexpr int CD_SCAL = 0;
constexpr int CD_A = 1024;
constexpr int CD_TB = CD_A + 64 * 272;
constexpr int CD_QN = CD_TB + 64 * 144;
constexpr int CD_KN = CD_QN + 64 * 272;
constexpr int CD_VBT = CD_KN + 64 * 272;
constexpr int CD_KBGT = CD_VBT + 128 * 144;
constexpr int CD_KDT = CD_KBGT + 128 * 144;
constexpr int CD_END = CD_KDT + 128 * 136;
static_assert(CD_END <= LDS_BYTES, "phase C delta LDS");
constexpr int CH_TOT = 0;
constexpr int CH_QH = 2048;
constexpr int CH_KH = CH_QH + 64 * 272;
constexpr int CH_KTT = CH_KH + 160 * 272;
constexpr int CH_VT = CH_KTT + 128 * 144;
constexpr int CH_AB = CH_VT + 128 * 144;
constexpr int CH_END = CH_AB + 64 * 144;
static_assert(CH_END <= LDS_BYTES, "phase C hgrn LDS");

struct DeltaIn { unsigned xr[3][11]; float aa, ba; };
DI void delta_load(const Params& P, int b, int h, int c, DeltaIn& in) {
    int tid_ = threadIdx.x; asm volatile("" : "+v"(tid_));
    const int lane = tid_ & 63, t0 = (tid_ >> 6) * 8;
    const bf16_t* PROJ = (const bf16_t*)(P.ws + WS_PROJ);
    const float* AB = (const float*)(P.ws + WS_AB);
    const int R0 = b * SEQ + c * CH;
#pragma unroll
    for (int m = 0; m < 3; ++m)
#pragma unroll
        for (int j = 0; j < 11; ++j) { const int t = t0 - 3 + j; in.xr[m][j] = (c > 0 || t >= 0) ? *(const unsigned*)(PROJ + (size_t)(R0 + t) * NIN + m * 512 + h * DH + 2 * lane) : 0u; }
    in.aa = AB[(size_t)(R0 + lane) * 8 + h]; in.ba = AB[(size_t)(R0 + lane) * 8 + 4 + h];
}
DI void chunk_delta(const Params& P, int l, int b, int h, int c, LAS unsigned char* lds, const DeltaIn& in) {
    int tid_ = threadIdx.x; asm volatile("" : "+v"(tid_));
    const int tid = tid_, lane = tid & 63, wave = tid >> 6;
    unsigned char* ws = P.ws;
    const int R0 = b * SEQ + c * CH;
    unsigned char* pack = ws + WS_DPACK + (size_t)((b * NH + h) * NCH + c) * DPACK_STRIDE;
    LAS float* scal = (LAS float*)(lds + CD_SCAL);
    const int t0 = wave * 8;
    if (wave == 0) {
        const float aa = in.aa, ba = in.ba;
        const float xx = aa + P.dt_bias[l * NH + h];
        const float sp = xx > 20.f ? xx : log1pf(expf(xx));
        float g = -expf(P.a_log[l * NH + h]) * sp;
        const float beta = 1.f / (1.f + expf(-ba));
        float Gc = g;
#pragma unroll
        for (int o = 1; o < 64; o <<= 1) { const float t = __shfl_up(Gc, o); if (lane >= o) Gc += t; }
        const float Gl = __shfl(Gc, 63);
        scal[lane] = beta; scal[64 + lane] = Gc; scal[128 + lane] = expf(Gc); scal[192 + lane] = expf(Gl - Gc);
        if (lane == 0) *(float*)(pack + DP_GL) = expf(Gl);
    }
    __syncthreads();
    {
        const float* cw = P.conv_w + (size_t)l * 4 * CONVD;
#pragma unroll
        for (int m = 0; m < 3; ++m) {
            const int chan = m * 512 + h * DH + 2 * lane;
            f32x2 w[4];
#pragma unroll
            for (int j = 0; j < 4; ++j) w[j] = *(const f32x2*)(cw + j * CONVD + chan);
            unsigned pa[2][4], pb[2][4];
#pragma unroll
            for (int tt = 0; tt < 8; ++tt) {
                const int t = t0 + tt;
                const f32x2 x0 = {bflo(in.xr[m][tt]), bfhi(in.xr[m][tt])}, x1 = {bflo(in.xr[m][tt + 1]), bfhi(in.xr[m][tt + 1])}, x2 = {bflo(in.xr[m][tt + 2]), bfhi(in.xr[m][tt + 2])}, x3 = {bflo(in.xr[m][tt + 3]), bfhi(in.xr[m][tt + 3])};
                f32x2 y = x0 * w[0] + x1 * w[1] + x2 * w[2] + x3 * w[3];
                y.x = siluf_(y.x); y.y = siluf_(y.y);
                if (c == NCH - 1 && t >= CH - 3) *(f32x2*)(P.out + OUT_CP + ((size_t)(l * NB + b) * 3 + (t - (CH - 3))) * CONVD + chan) = x3;
                const float beta = scal[t], eG = scal[128 + t], eGl = scal[192 + t];
                if (m == 0) {
                    const float rs = rsqrtf(wave_sum(y.x * y.x + y.y * y.y) + EPS) * 0.08838834764831845f;
                    y = y * rs;
                    *(LAS unsigned*)(lds + CD_QN + t * 272 + 4 * lane) = pk2(y.x, y.y);
                    *(unsigned*)(pack + DP_QD + t * R128 + 4 * lane) = pk2(y.x * eG, y.y * eG);
                } else if (m == 1) {
                    const float rs = rsqrtf(wave_sum(y.x * y.x + y.y * y.y) + EPS);
                    y = y * rs;
                    *(LAS unsigned*)(lds + CD_KN + t * 272 + 4 * lane) = pk2(y.x, y.y);
                    const float s1 = beta * eG;
                    if (tt & 1) { pa[0][tt >> 1] |= (unsigned)f2bf(y.x * s1) << 16; pa[1][tt >> 1] |= (unsigned)f2bf(y.y * s1) << 16; pb[0][tt >> 1] |= (unsigned)f2bf(y.x * eGl) << 16; pb[1][tt >> 1] |= (unsigned)f2bf(y.y * eGl) << 16; }
                    else { pa[0][tt >> 1] = f2bf(y.x * s1); pa[1][tt >> 1] = f2bf(y.y * s1); pb[0][tt >> 1] = f2bf(y.x * eGl); pb[1][tt >> 1] = f2bf(y.y * eGl); }
                } else {
                    if (tt & 1) { pa[0][tt >> 1] |= (unsigned)f2bf(y.x * beta) << 16; pa[1][tt >> 1] |= (unsigned)f2bf(y.y * beta) << 16; }
                    else { pa[0][tt >> 1] = f2bf(y.x * beta); pa[1][tt >> 1] = f2bf(y.y * beta); }
                }
            }
            if (m == 1) {
#pragma unroll
                for (int e = 0; e < 2; ++e) {
                    *(LAS u32x4*)(lds + CD_KBGT + (2 * lane + e) * 144 + 2 * t0) = (u32x4){pa[e][0], pa[e][1], pa[e][2], pa[e][3]};
                    *(LAS u32x2*)(lds + CD_KDT + (2 * lane + e) * 136 + 2 * t0) = (u32x2){pb[e][0], pb[e][1]};
                    *(LAS u32x2*)(lds + CD_KDT + (2 * lane + e) * 136 + 2 * t0 + 8) = (u32x2){pb[e][2], pb[e][3]};
                }
            } else if (m == 2) {
#pragma unroll
                for (int e = 0; e < 2; ++e) *(LAS u32x4*)(lds + CD_VBT + (2 * lane + e) * 144 + 2 * t0) = (u32x4){pa[e][0], pa[e][1], pa[e][2], pa[e][3]};
            }
        }
    }
    __syncthreads();
    {
        const int fr = lane & 15, fq = lane >> 4;
#pragma unroll
        for (int e = 0; e < 2; ++e) {
            const int ti = (2 * wave + e) >> 2, tj = (2 * wave + e) & 3;
            f32x4 acc = {0.f, 0.f, 0.f, 0.f};
            if (tj <= ti) {
#pragma unroll
                for (int ks = 0; ks < 4; ++ks) {
                    const bf16x8 a = lds_frag16(lds + CD_KN + (16 * tj + fr) * 272 + (32 * ks + 8 * fq) * 2);
                    const bf16x8 bq = lds_frag16(lds + CD_QN + (16 * ti + fr) * 272 + (32 * ks + 8 * fq) * 2);
                    acc = MFMA16(a, bq, acc);
                }
            }
            {
                const int i = 16 * ti + fr; const float Gi = scal[64 + i]; float r[4];
#pragma unroll
                for (int jj = 0; jj < 4; ++jj) { const int j = 16 * tj + 4 * fq + jj; r[jj] = (j <= i) ? acc[jj] * __expf(Gi - scal[64 + j]) : 0.f; }
                u32x2 o; o.x = pk2(r[0], r[1]); o.y = pk2(r[2], r[3]);
                *(u32x2*)(pack + DP_QK + i * R64 + (16 * tj + 4 * fq) * 2) = o;
            }
            if (tj <= ti) {
                f32x4 acc2 = {0.f, 0.f, 0.f, 0.f};
#pragma unroll
                for (int ks = 0; ks < 4; ++ks) {
                    const bf16x8 a = lds_frag16(lds + CD_KN + (16 * ti + fr) * 272 + (32 * ks + 8 * fq) * 2);
                    const bf16x8 bk = lds_frag16(lds + CD_KN + (16 * tj + fr) * 272 + (32 * ks + 8 * fq) * 2);
                    acc2 = MFMA16(a, bk, acc2);
                }
                const int j = 16 * tj + fr; const float Gj = scal[64 + j];
#pragma unroll
                for (int jj = 0; jj < 4; ++jj) { const int i = 16 * ti + 4 * fq + jj;
                    *(LAS float*)(lds + CD_A + (i * 68 + j) * 4) = (j < i) ? scal[i] * acc2[jj] * __expf(scal[64 + i] - Gj) : 0.f; }
            }
        }
    }
    __syncthreads();
    {
        const LAS float* A = (const LAS float*)(lds + CD_A);
        LAS float* Xl = (LAS float*)(lds + CD_QN);
        LAS float* Wl = (LAS float*)(lds + CD_KN) + wave * 256;
        const int fr = lane & 15, fq = lane >> 4;
        if (wave == 0) {
            const int blk = fq, cc = fr;
            const LAS float* Ab = A + (16 * blk) * 68 + 16 * blk;
            float tc[16];
#pragma unroll
            for (int i = 0; i < 16; ++i) {
                float a0 = (i == cc) ? 1.f : 0.f, a1 = 0.f;
#pragma unroll
                for (int j = 0; j < i; ++j) { const float p = Ab[i * 68 + j] * tc[j]; if (j & 1) a1 -= p; else a0 -= p; }
                tc[i] = a0 + a1;
            }
#pragma unroll
            for (int i = 0; i < 16; ++i) Xl[(16 * blk + i) * 68 + 16 * blk + cc] = tc[i];
        } else {
            for (int e = tid - 64; e < 128 * 136 / 16; e += 448) *(u32x4*)(pack + DP_KDT + e * 16) = *(const LAS u32x4*)(lds + CD_KDT + e * 16);
        }
        __syncthreads();
#pragma unroll
        for (int d = 1; d < 4; ++d) {
            if (wave < 4 - d) {
                const int b = d + wave, cb = wave;
                f32x4 w = {0.f, 0.f, 0.f, 0.f};
#pragma unroll
                for (int kk = 0; kk < d; ++kk) { const int k = cb + kk;
#pragma unroll
                    for (int s4 = 0; s4 < 4; ++s4)
                        w = __builtin_amdgcn_mfma_f32_16x16x4f32(A[(16 * b + fr) * 68 + 16 * k + 4 * s4 + fq], Xl[(16 * k + 4 * s4 + fq) * 68 + 16 * cb + fr], w, 0, 0, 0);
                }
#pragma unroll
                for (int r4 = 0; r4 < 4; ++r4) Wl[(4 * fq + r4) * 16 + fr] = w[r4];
                f32x4 x2 = {0.f, 0.f, 0.f, 0.f};
#pragma unroll
                for (int s4 = 0; s4 < 4; ++s4)
                    x2 = __builtin_amdgcn_mfma_f32_16x16x4f32(Xl[(16 * b + fr) * 68 + 16 * b + 4 * s4 + fq], Wl[(4 * s4 + fq) * 16 + fr], x2, 0, 0, 0);
#pragma unroll
                for (int r4 = 0; r4 < 4; ++r4) Xl[(16 * b + 4 * fq + r4) * 68 + 16 * cb + fr] = -x2[r4];
            }
            __syncthreads();
        }
        {
            const int i = tid >> 3, j0 = (tid & 7) * 8;
            u32x4 o = {0u, 0u, 0u, 0u};
            if ((j0 >> 4) <= (i >> 4)) { const f32x4 x0 = *(const LAS f32x4*)(Xl + i * 68 + j0), x1 = *(const LAS f32x4*)(Xl + i * 68 + j0 + 4);
                o.x = pk2(x0.x, x0.y); o.y = pk2(x0.z, x0.w); o.z = pk2(x1.x, x1.y); o.w = pk2(x1.z, x1.w); }
            *(LAS u32x4*)(lds + CD_TB + i * 144 + 2 * j0) = o;
        }
    }
    __syncthreads();
    {
        const int fr = lane & 15, fq = lane >> 4;
        const int ti = wave >> 1;
        bf16x8 ta[2];
#pragma unroll
        for (int ks = 0; ks < 2; ++ks) ta[ks] = lds_frag16(lds + CD_TB + (16 * ti + fr) * 144 + (32 * ks + 8 * fq) * 2);
#pragma unroll
        for (int e = 0; e < 4; ++e) {
            const int tv = 4 * (wave & 1) + e;
            f32x4 acc = {0.f, 0.f, 0.f, 0.f};
#pragma unroll
            for (int ks = 0; ks < 2; ++ks) acc = MFMA16(ta[ks], lds_frag16(lds + CD_VBT + (16 * tv + fr) * 144 + (32 * ks + 8 * fq) * 2), acc);
            u32x2 o; o.x = pk2(acc[0], acc[1]); o.y = pk2(acc[2], acc[3]);
            *(u32x2*)(pack + DP_UT + (16 * tv + fr) * R64 + (16 * ti + 4 * fq) * 2) = o;
        }
        bf16x8 ka[2];
#pragma unroll
        for (int ks = 0; ks < 2; ++ks) ka[ks] = lds_frag16(lds + CD_KBGT + (16 * wave + fr) * 144 + (32 * ks + 8 * fq) * 2);
#pragma unroll
        for (int ti2 = 0; ti2 < 4; ++ti2) {
            f32x4 acc = {0.f, 0.f, 0.f, 0.f};
#pragma unroll
            for (int ks = 0; ks < 2; ++ks) acc = MFMA16(ka[ks], lds_frag16(lds + CD_TB + (16 * ti2 + fr) * 144 + (32 * ks + 8 * fq) * 2), acc);
            u32x2 o; o.x = pk2(-acc[0], -acc[1]); o.y = pk2(-acc[2], -acc[3]);
            *(u32x2*)(pack + DP_NW + (16 * ti2 + fr) * R128 + (16 * wave + 4 * fq) * 2) = o;
        }
    }
    __syncthreads();
}

struct HgrnIn { unsigned short fb[16], qb[16], ib[16]; };
DI void hgrn_load(const Params& P, int b, int h, int c, HgrnIn& in) {
    int tid_ = threadIdx.x; asm volatile("" : "+v"(tid_));
    const int dk = tid_ & 127, a = tid_ >> 7;
    const bf16_t* PROJ = (const bf16_t*)(P.ws + WS_PROJ);
    const int R0 = b * SEQ + c * CH;
#pragma unroll
    for (int i = 0; i < 16; ++i) { const size_t ro = (size_t)(R0 + 16 * a + i) * NIN + h * DH + dk; in.fb[i] = PROJ[ro + PC_FB]; in.qb[i] = PROJ[ro + PC_QB]; in.ib[i] = PROJ[ro + PC_IB]; }
}
template <bool DRY>
DI void chunk_hgrn(const Params& P, int l, int b, int h, int c, LAS unsigned char* lds, const HgrnIn& in) {
    int tid_ = threadIdx.x; asm volatile("" : "+v"(tid_));
    const int tid = tid_, lane = tid & 63, wave = tid >> 6;
    unsigned char* ws = P.ws;
    bf16_t* PROJ = (bf16_t*)(ws + WS_PROJ);
    bf16_t* MIX = (bf16_t*)(ws + WS_H);
    const int R0 = b * SEQ + c * CH;
    unsigned char* hp = ws + WS_HPACK + (size_t)((b * NH + h) * NCH + c) * HPACK_STRIDE;
    LAS float* tot = (LAS float*)(lds + CH_TOT);
    {
        const int dk = tid & 127, a = tid >> 7;
        const float lbv = ((const float*)(ws + WS_LB))[l * 512 + h * DH + dk];
        float kk[16], qq[16], gl[16]; float run = 0.f;
#pragma unroll
        for (int i = 0; i < 16; ++i) {
            const float fb = bf2f(in.fb[i]), qb = bf2f(in.qb[i]);
            const float f = lbv + (1.f - lbv) * sigmoidf_(fb);
            run += __logf(f);
            gl[i] = run; kk[i] = 1.f - f; qq[i] = siluf_(qb);
        }
        tot[a * 128 + dk] = run;
        __syncthreads();
        float G0[5]; G0[0] = 0.f;
#pragma unroll
        for (int x = 0; x < 4; ++x) G0[x + 1] = G0[x] + tot[x * 128 + dk];
        const float g0a = a == 0 ? G0[0] : a == 1 ? G0[1] : a == 2 ? G0[2] : G0[3];
        const float gtot = G0[4];
        if (a == 0) *(float*)(hp + 32768 + 4 * dk) = __expf(gtot);
        const float eg0 = __expf(g0a);
        unsigned kt[8];
#pragma unroll
        for (int i = 0; i < 16; ++i) {
            const int t = 16 * a + i;
            const float qh = qq[i] * __expf(gl[i]);
            *(LAS unsigned short*)(lds + CH_QH + t * 272 + 2 * dk) = f2bf(qh);
            if (!DRY) PROJ[(size_t)(R0 + t) * NIN + PC_QB + h * DH + dk] = f2bf(qh * eg0);
#pragma unroll
            for (int ap = 0; ap < 4; ++ap) {
                if (ap >= a) {
                    const float ex = fminf(G0[ap] - g0a - gl[i], 80.f);
                    const int rowbase = ap == 0 ? 0 : ap == 1 ? 16 : ap == 2 ? 48 : 96;
                    *(LAS unsigned short*)(lds + CH_KH + (rowbase + t) * 272 + 2 * dk) = f2bf(kk[i] * __expf(ex));
                }
            }
            const float ktv = kk[i] * __expf(gtot - g0a - gl[i]);
            if (i & 1) kt[i >> 1] |= ((unsigned)f2bf(ktv)) << 16; else kt[i >> 1] = f2bf(ktv);
        }
        *(LAS u32x4*)(lds + CH_KTT + dk * 144 + 32 * a) = (u32x4){kt[0], kt[1], kt[2], kt[3]};
        *(LAS u32x4*)(lds + CH_KTT + dk * 144 + 32 * a + 16) = (u32x4){kt[4], kt[5], kt[6], kt[7]};
        unsigned vt[8];
#pragma unroll
        for (int i = 0; i < 16; ++i) { const unsigned short u = in.ib[i]; if (i & 1) vt[i >> 1] |= ((unsigned)u) << 16; else vt[i >> 1] = u; }
        *(LAS u32x4*)(lds + CH_VT + dk * 144 + 32 * a) = (u32x4){vt[0], vt[1], vt[2], vt[3]};
        *(LAS u32x4*)(lds + CH_VT + dk * 144 + 32 * a + 16) = (u32x4){vt[4], vt[5], vt[6], vt[7]};
    }
    __syncthreads();
    const int fr = lane & 15, fq = lane >> 4;
#pragma unroll
    for (int e = 0; e < 2; ++e) {
        const int a = (wave + 8 * e) >> 2, bb = (wave + 8 * e) & 3;
        f32x4 acc = {0.f, 0.f, 0.f, 0.f};
        if (bb <= a) {
            const int rowbase = a == 0 ? 0 : a == 1 ? 16 : a == 2 ? 48 : 96;
#pragma unroll
            for (int ks = 0; ks < 4; ++ks)
                acc = MFMA16(lds_frag16(lds + CH_QH + (16 * a + fr) * 272 + (32 * ks + 8 * fq) * 2), lds_frag16(lds + CH_KH + (rowbase + 16 * bb + fr) * 272 + (32 * ks + 8 * fq) * 2), acc);
        }
#pragma unroll
        for (int jj = 0; jj < 4; ++jj) { const int i = 16 * a + 4 * fq + jj, j = 16 * bb + fr;
            *(LAS unsigned short*)(lds + CH_AB + i * 144 + 2 * j) = f2bf(j <= i ? acc[jj] : 0.f); }
    }
    __syncthreads();
    {
        bf16x8 va[2];
#pragma unroll
        for (int ks = 0; ks < 2; ++ks) va[ks] = lds_frag16(lds + CH_VT + (16 * wave + fr) * 144 + (32 * ks + 8 * fq) * 2);
#pragma unroll
        for (int ti = 0; ti < 4; ++ti) {
            f32x4 acc = {0.f, 0.f, 0.f, 0.f};
#pragma unroll
            for (int ks = 0; ks < 2; ++ks) acc = MFMA16(va[ks], lds_frag16(lds + CH_AB + (16 * ti + fr) * 144 + (32 * ks + 8 * fq) * 2), acc);
            u32x2 o; o.x = pk2(acc[0], acc[1]); o.y = pk2(acc[2], acc[3]);
            if (!DRY) *(u32x2*)(MIX + (size_t)(R0 + 16 * ti + fr) * DM + 512 + h * DH + 16 * wave + 4 * fq) = o;
        }
        bf16x8 ka[2];
#pragma unroll
        for (int ks = 0; ks < 2; ++ks) ka[ks] = lds_frag16(lds + CH_KTT + (16 * wave + fr) * 144 + (32 * ks + 8 * fq) * 2);
        unsigned* img = (unsigned*)hp;
#pragma unroll
        for (int tv = 0; tv < 8; ++tv) {
            f32x4 acc = {0.f, 0.f, 0.f, 0.f};
#pragma unroll
            for (int ks = 0; ks < 2; ++ks) acc = MFMA16(ka[ks], lds_frag16(lds + CH_VT + (16 * tv + fr) * 144 + (32 * ks + 8 * fq) * 2), acc);
            const int a32 = wave >> 1, hh = fq & 1, p0 = 4 * (wave & 1) + 2 * (fq >> 1);
            const int dv = 16 * tv + fr, w = dv >> 5, r = dv & 31;
            img[((w * 4 + a32) * 8 + p0) * 64 + hh * 32 + r] = pk2(acc[0], acc[1]);
            img[((w * 4 + a32) * 8 + p0 + 1) * 64 + hh * 32 + r] = pk2(acc[2], acc[3]);
        }
    }
    __syncthreads();
}

DI void phase_chunks(const Params& P, int l, LAS unsigned char* lds) {
    DeltaIn din;
    { const int item = blockIdx.x; if (item < NB * NH * NCH) delta_load(P, item >> 7, (item >> 5) & 3, item & 31, din); }
    for (int item = blockIdx.x; item < NB * NH * NCH; item += gridDim.x) {
        const int c = item & 31, h = (item >> 5) & 3, b = item >> 7;
        HgrnIn hin; hgrn_load(P, b, h, c, hin);
        chunk_delta(P, l, b, h, c, lds, din);
#ifdef REP_CD
        chunk_delta(P, l, b, h, c, lds, din);
#endif
        { const int nitem = item + gridDim.x; if (nitem < NB * NH * NCH) delta_load(P, nitem >> 7, (nitem >> 5) & 3, nitem & 31, din); }
#ifdef REP_CH
        chunk_hgrn<true>(P, l, b, h, c, lds, hin);
#endif
        chunk_hgrn<false>(P, l, b, h, c, lds, hin);
    }
}
constexpr int SS_BLOC = 34816;
constexpr int SS_OBUF = 77568, SS_OBUF_SZ = 64 * 132 * 4, SS_DVEC = SS_OBUF + 2 * SS_OBUF_SZ, SS_END = SS_DVEC + 512;
static_assert(SS_END <= LDS_MISC, "scan LDS");

DI bf16x8 pack_acc(const f32x16& x, int s) {
    u32x4 p;
    p.x = pk2(x[8 * s + 0], x[8 * s + 1]); p.y = pk2(x[8 * s + 2], x[8 * s + 3]); p.z = pk2(x[8 * s + 4], x[8 * s + 5]); p.w = pk2(x[8 * s + 6], x[8 * s + 7]);
    return __builtin_bit_cast(bf16x8, p);
}
DI bf16x8 lds_frag32(const LAS unsigned char* rowp, int e0) {
    const u32x2 lo = *(const LAS u32x2*)(rowp + 2 * e0), hi = *(const LAS u32x2*)(rowp + 2 * e0 + 16);
    u32x4 p = {lo.x, lo.y, hi.x, hi.y};
    return __builtin_bit_cast(bf16x8, p);
}

#define BAR_LDS() do { asm volatile("s_waitcnt lgkmcnt(0)" ::: "memory"); __builtin_amdgcn_s_barrier(); asm volatile("" ::: "memory"); } while (0)
template <bool DELTA>
DI void scan_prompt(const Params& P, int l, int bh, LAS unsigned char* lds) {
    int tid_ = threadIdx.x; asm volatile("" : "+v"(tid_));
    const int tid = tid_, lane = tid & 63, wave = __builtin_amdgcn_readfirstlane(tid >> 6);
    const int r = lane & 31, hh = lane >> 5;
    unsigned char* ws = P.ws;
    const int b = bh >> 2, h = bh & 3;
    const bf16_t* PROJ = (const bf16_t*)(ws + WS_PROJ);
    bf16_t* MIX = (bf16_t*)(ws + WS_H);
    LAS float* obuf = (LAS float*)(lds + SS_OBUF);
    LAS float* dvec = (LAS float*)(lds + SS_DVEC);
    const float* normw = (DELTA ? P.norm_a : P.norm_b) + l * DH;
    __syncthreads();
    if (DELTA) {
        const unsigned char* pack = ws + WS_DPACK + (size_t)(bh * NCH) * DPACK_STRIDE;
        for (int e = tid; e < DP_BYTES / 16; e += 512) *(LAS u32x4*)(lds + e * 16) = *(const u32x4*)(pack + e * 16);
    } else {
        const unsigned char* hp = ws + WS_HPACK + (size_t)(bh * NCH) * HPACK_STRIDE;
        for (int e = tid; e < 64 * 16; e += 512) { const u32x4 v = *(const u32x4*)(PROJ + (size_t)(b * SEQ + (e >> 4)) * NIN + PC_QB + h * DH + (e & 15) * 8);
            LAS unsigned char* d = lds + DP_QD + (e >> 4) * R128 + (e & 15) * 16; *(LAS u32x2*)d = (u32x2){v.x, v.y}; *(LAS u32x2*)(d + 8) = (u32x2){v.z, v.w}; }
        for (int e = tid; e < 2048; e += 512) *(LAS u32x4*)(lds + SS_BLOC + e * 16) = *(const u32x4*)(hp + e * 16);
        if (tid < 128) dvec[tid] = *(const float*)(hp + 32768 + 4 * tid);
    }
#define SCAN_PREFETCH(c_, gz_, ol_) do { const int R0_ = b * SEQ + (c_) * CH; int lane = lane0; asm volatile("" : "+v"(lane)); \
        _Pragma("unroll") for (int p_ = 0; p_ < 2; ++p_) { const int t = (wave - 4) * 16 + 8 * p_ + (lane >> 3); \
            const bf16_t* gp_ = PROJ + (size_t)(R0_ + t) * NIN + (DELTA ? PC_ZA : PC_OB) + h * DH + 16 * (lane & 7); \
            gz_[2 * p_] = *(const u32x4*)gp_; gz_[2 * p_ + 1] = *(const u32x4*)(gp_ + 8); \
            if (!DELTA) { const bf16_t* op_ = MIX + (size_t)(R0_ + t) * DM + 512 + h * DH + 16 * (lane & 7); ol_[2 * p_] = *(const u32x4*)op_; ol_[2 * p_ + 1] = *(const u32x4*)(op_ + 8); } } } while (0)
#define SCAN_FINISH(c_, gz_, ol_) do { const int R0_ = b * SEQ + (c_) * CH; int lane = lane0; asm volatile("" : "+v"(lane)); \
        const LAS float* ob_ = (const LAS float*)(lds + SS_OBUF + ((c_) & 1) * SS_OBUF_SZ); \
        _Pragma("unroll") for (int p_ = 0; p_ < 2; ++p_) { const int t = (wave - 4) * 16 + 8 * p_ + (lane >> 3); \
            float o_[16]; \
            _Pragma("unroll") for (int q_ = 0; q_ < 4; ++q_) { const f32x4 v_ = *(const LAS f32x4*)(ob_ + t * 132 + 16 * (lane & 7) + 4 * q_); o_[4 * q_] = v_.x; o_[4 * q_ + 1] = v_.y; o_[4 * q_ + 2] = v_.z; o_[4 * q_ + 3] = v_.w; } \
            if (!DELTA) { _Pragma("unroll") for (int q_ = 0; q_ < 8; ++q_) { const unsigned w_ = ol_[2 * p_ + (q_ >> 2)][q_ & 3]; o_[2 * q_] += bflo(w_); o_[2 * q_ + 1] += bfhi(w_); } } \
            float ss_ = 0.f; \
            _Pragma("unroll") for (int q_ = 0; q_ < 16; ++q_) ss_ += o_[q_] * o_[q_]; \
            ss_ += dpp_<0xB1>(ss_); ss_ += dpp_<0x4E>(ss_); ss_ += dpp_<0x141>(ss_); \
            const float rs_ = rsqrtf(ss_ * (1.f / DH) + EPS); \
            unsigned pk_[8]; \
            _Pragma("unroll") for (int q_ = 0; q_ < 8; ++q_) { const unsigned w_ = gz_[2 * p_ + (q_ >> 2)][q_ & 3]; \
                pk_[q_] = pk2(o_[2 * q_] * rs_ * nwv[2 * q_] * bflo(w_), o_[2 * q_ + 1] * rs_ * nwv[2 * q_ + 1] * bfhi(w_)); } \
            bf16_t* mp_ = MIX + (size_t)(R0_ + t) * DM + (DELTA ? 0 : 512) + h * DH + 16 * (lane & 7); \
            *(u32x4*)mp_ = (u32x4){pk_[0], pk_[1], pk_[2], pk_[3]}; *(u32x4*)(mp_ + 8) = (u32x4){pk_[4], pk_[5], pk_[6], pk_[7]}; } } while (0)
    if (wave < 4) {
        const int dv0 = 32 * wave;
        f32x16 S[4];
#pragma unroll
        for (int a = 0; a < 4; ++a)
#pragma unroll
            for (int i = 0; i < 16; ++i) S[a][i] = 0.f;
        for (int c = 0; c < NCH; ++c) {
            BAR_LDS();
            bf16x8 Spk[4][2];
#pragma unroll
            for (int a = 0; a < 4; ++a)
#pragma unroll
                for (int s = 0; s < 2; ++s) Spk[a][s] = pack_acc(S[a], s);
            f32x16 O[2], V[2]; bf16x8 Vpk[2][2];
#pragma unroll
            for (int mt = 0; mt < 2; ++mt)
#pragma unroll
                for (int i = 0; i < 16; ++i) O[mt][i] = 0.f;
            constexpr int NG = DELTA ? 14 : 4;
            bf16x8 fb[2][4];
#define LOAD_GROUP(g_, f_) do { \
                _Pragma("unroll") for (int i_ = 0; i_ < 4; ++i_) { \
                    if ((g_) < 8) f_[i_] = lds_frag32(lds + ((g_) < 4 ? DP_QD : DP_NW) + (32 * (i_ & 1) + r) * R128 + 64 * ((g_) & 3), 16 * (i_ >> 1) + 4 * hh); \
                    else if ((g_) < 10) f_[i_] = lds_frag32(lds + DP_QK + (32 * (i_ & 1) + r) * R64 + 64 * ((g_) - 8), 16 * (i_ >> 1) + 4 * hh); \
                    else f_[i_] = lds_frag32(lds + DP_KDT + (32 * i_ + r) * R64 + 64 * (((g_) - 10) >> 1), 16 * (((g_) - 10) & 1) + 4 * hh); } } while (0)
            LOAD_GROUP(0, fb[0]);
            if (DELTA) {
#pragma unroll
                for (int mt = 0; mt < 2; ++mt)
#pragma unroll
                    for (int g = 0; g < 4; ++g) { const u32x2 u = *(const LAS u32x2*)(lds + DP_UT + (dv0 + r) * R64 + (32 * mt + 8 * g + 4 * hh) * 2);
                        V[mt][4 * g + 0] = bflo(u.x); V[mt][4 * g + 1] = bfhi(u.x); V[mt][4 * g + 2] = bflo(u.y); V[mt][4 * g + 3] = bfhi(u.y); }
            }
            float gl = 1.f; if (DELTA) gl = *(const LAS float*)(lds + DP_GL);
#pragma unroll
            for (int g = 0; g < NG; ++g) {
                if (g + 1 < NG) LOAD_GROUP(g + 1, fb[(g + 1) & 1]);
                __builtin_amdgcn_sched_barrier(0);
                if (g == 8) {
#pragma unroll
                    for (int mt = 0; mt < 2; ++mt)
#pragma unroll
                        for (int s = 0; s < 2; ++s) Vpk[mt][s] = pack_acc(V[mt], s);
                }
                if (g == 10) {
#pragma unroll
                    for (int a = 0; a < 4; ++a)
#pragma unroll
                        for (int i = 0; i < 16; ++i) S[a][i] *= gl;
                }
#pragma unroll
                for (int i = 0; i < 4; ++i) {
                    if (g < 4) O[i & 1] = MFMA32(fb[g & 1][i], Spk[g][i >> 1], O[i & 1]);
                    else if (g < 8) V[i & 1] = MFMA32(fb[g & 1][i], Spk[g - 4][i >> 1], V[i & 1]);
                    else if (g < 10) O[i & 1] = MFMA32(fb[g & 1][i], Vpk[g - 8][i >> 1], O[i & 1]);
                    else S[i] = MFMA32(fb[g & 1][i], Vpk[(g - 10) >> 1][(g - 10) & 1], S[i]);
                }
                __builtin_amdgcn_sched_barrier(0);
            }
#undef LOAD_GROUP
            if (!DELTA) {
#pragma unroll
                for (int a = 0; a < 4; ++a)
#pragma unroll
                    for (int g = 0; g < 4; ++g) { const f32x4 d4 = *(const LAS f32x4*)(dvec + 32 * a + 8 * g + 4 * hh);
#pragma unroll
                        for (int e = 0; e < 4; ++e) { const int i = 4 * g + e; const unsigned w = *(const LAS unsigned*)(lds + SS_BLOC + (((wave * 4 + a) * 8 + (i >> 1)) * 64 + lane) * 4); S[a][i] = d4[e] * S[a][i] + ((i & 1) ? bfhi(w) : bflo(w)); } }
            }
#pragma unroll
            for (int mt = 0; mt < 2; ++mt)
#pragma unroll
                for (int i = 0; i < 16; ++i) obuf[(c & 1) * (SS_OBUF_SZ / 4) + (32 * mt + (i & 3) + 8 * (i >> 2) + 4 * hh) * 132 + dv0 + r] = O[mt][i];
            BAR_LDS();
        }
        float* so = P.out + (DELTA ? OUT_DP : OUT_HP) + ((size_t)(l * NB + b) * NH + h) * DH * DH;
#pragma unroll
        for (int a = 0; a < 4; ++a)
#pragma unroll
            for (int i = 0; i < 16; ++i) so[(size_t)(32 * a + (i & 3) + 8 * (i >> 2) + 4 * hh) * DH + dv0 + r] = S[a][i];
    } else {
        const int tl0 = tid - 256, lane0 = lane;
        u32x4 stgA[DELTA ? 19 : 12]; float dnA = 0.f;
#define LD_IMG(cc_, stg_, dn_) do { int tl = tl0; asm volatile("" : "+v"(tl)); \
            if (DELTA) { const unsigned char* pack = ws + WS_DPACK + (size_t)(bh * NCH + (cc_)) * DPACK_STRIDE; \
                _Pragma("unroll") for (int i = 0; i < 19; ++i) { const int e = tl + 256 * i; if (i < 18 || e < DP_BYTES / 16) stg_[i] = *(const u32x4*)(pack + e * 16); } \
            } else { const unsigned char* hp = ws + WS_HPACK + (size_t)(bh * NCH + (cc_)) * HPACK_STRIDE; const int R1 = b * SEQ + (cc_) * CH; \
                _Pragma("unroll") for (int i = 0; i < 4; ++i) { const int e = tl + 256 * i; stg_[i] = *(const u32x4*)(PROJ + (size_t)(R1 + (e >> 4)) * NIN + PC_QB + h * DH + (e & 15) * 8); } \
                _Pragma("unroll") for (int i = 0; i < 8; ++i) stg_[4 + i] = *(const u32x4*)(hp + (tl + 256 * i) * 16); \
                if (tl < 128) dn_ = *(const float*)(hp + 32768 + 4 * tl); } } while (0)
#define ST_IMG(stg_, dn_) do { int tl = tl0; asm volatile("" : "+v"(tl)); \
            if (DELTA) { _Pragma("unroll") for (int i = 0; i < 19; ++i) { const int e = tl + 256 * i; if (i < 18 || e < DP_BYTES / 16) *(LAS u32x4*)(lds + e * 16) = stg_[i]; } \
            } else { _Pragma("unroll") for (int i = 0; i < 4; ++i) { const int e = tl + 256 * i; LAS unsigned char* d = lds + DP_QD + (e >> 4) * R128 + (e & 15) * 16; \
                    *(LAS u32x2*)d = (u32x2){stg_[i].x, stg_[i].y}; *(LAS u32x2*)(d + 8) = (u32x2){stg_[i].z, stg_[i].w}; } \
                _Pragma("unroll") for (int i = 0; i < 8; ++i) *(LAS u32x4*)(lds + SS_BLOC + (tl + 256 * i) * 16) = stg_[4 + i]; \
                if (tl < 128) dvec[tl] = dn_; } } while (0)
        u32x4 gzE[4], gzO[4], olE[4], olO[4];
        float nwv[16];
#pragma unroll
        for (int q = 0; q < 16; ++q) nwv[q] = normw[16 * (lane0 & 7) + q];
        for (int c = 0; c < NCH; c += 2) {
            BAR_LDS();
            SCAN_PREFETCH(c, gzE, olE);
            LD_IMG(c + 1, stgA, dnA);
            if (c > 0) SCAN_FINISH(c - 1, gzO, olO);
            BAR_LDS();
            ST_IMG(stgA, dnA);
            BAR_LDS();
            SCAN_PREFETCH(c + 1, gzO, olO);
            if (c + 2 < NCH) LD_IMG(c + 2, stgA, dnA);
            SCAN_FINISH(c, gzE, olE);
            BAR_LDS();
            if (c + 2 < NCH) ST_IMG(stgA, dnA);
        }
        SCAN_FINISH(NCH - 1, gzO, olO);
#undef LD_IMG
#undef ST_IMG
    }
#undef SCAN_FINISH
#undef SCAN_PREFETCH
    __syncthreads();
}

DI void sample_item(const Params& P, int l, int s, int h, LAS unsigned char* lds) {
    int tid_ = threadIdx.x; asm volatile("" : "+v"(tid_));
    const int tid = tid_, lane = tid & 63, wave = tid >> 6;
    unsigned char* ws = P.ws;
    const bf16_t* PROJ = (const bf16_t*)(ws + WS_PROJ);
    bf16_t* MIX = (bf16_t*)(ws + WS_H);
    const float* AB = (const float*)(ws + WS_AB);
    const int row = MP + s;
    LAS float* cv = (LAS float*)lds;
    LAS float* sc = (LAS float*)(lds + 2048);
    LAS float* part = (LAS float*)(lds + 4096);
    LAS float* fq_ = (LAS float*)(lds + 4096 + 8192);
    __syncthreads();
    if (tid < 384) {
        const int m = tid >> 7, ch = tid & 127, chan = m * 512 + h * DH + ch;
        const float* sb = P.state_conv + ((size_t)(l * MS + s) * 3) * CONVD + chan;
        const float b0 = sb[0], b1 = sb[CONVD], b2 = sb[2 * CONVD];
        const float xn = bf2f(PROJ[(size_t)row * NIN + chan]);
        const float* cw = P.conv_w + (size_t)l * 4 * CONVD + chan;
        const float y = siluf_(cw[0] * b0 + cw[CONVD] * b1 + cw[2 * CONVD] * b2 + cw[3 * CONVD] * xn);
        float* co = P.out + OUT_CS + ((size_t)(l * MS + s) * 3) * CONVD + chan;
        co[0] = b1; co[CONVD] = b2; co[2 * CONVD] = xn;
        cv[m * 128 + ch] = y;
    } else {
        const int dk = tid - 384;
        const float lbv = ((const float*)(ws + WS_LB))[l * 512 + h * DH + dk];
        const float fb = bf2f(PROJ[(size_t)row * NIN + PC_FB + h * DH + dk]), qb = bf2f(PROJ[(size_t)row * NIN + PC_QB + h * DH + dk]);
        fq_[dk] = lbv + (1.f - lbv) * sigmoidf_(fb); fq_[128 + dk] = siluf_(qb);
    }
    __syncthreads();
    if (wave < 2) { const f32x2 v = *(const LAS f32x2*)(cv + wave * 128 + 2 * lane); const float ss = wave_sum(v.x * v.x + v.y * v.y); if (lane == 0) sc[wave] = ss; }
    __syncthreads();
    const float rq = rsqrtf(sc[0] + EPS) * 0.08838834764831845f, rk = rsqrtf(sc[1] + EPS);
    const float aa = AB[(size_t)row * 8 + h], ba = AB[(size_t)row * 8 + 4 + h];
    const float xx = aa + P.dt_bias[l * NH + h];
    const float sp = xx > 20.f ? xx : log1pf(expf(xx));
    const float eg = expf(-expf(P.a_log[l * NH + h]) * sp);
    const float beta = 1.f / (1.f + expf(-ba));
    const int dvq = tid & 31, dkg = tid >> 5;
    const size_t sbase = ((size_t)(l * MS + s) * NH + h) * DH * DH;
    {
        const float* Sin = P.state_delta + sbase; float* Sout = P.out + OUT_DS + sbase;
        f32x4 St[8]; f32x4 kv = {0.f, 0.f, 0.f, 0.f};
#pragma unroll
        for (int i = 0; i < 8; ++i) { const int dk = dkg + 16 * i; St[i] = *(const f32x4*)(Sin + (size_t)dk * DH + 4 * dvq) * eg; kv += St[i] * (cv[128 + dk] * rk); }
        *(LAS f32x4*)(part + dkg * 128 + 4 * dvq) = kv;
        __syncthreads();
        f32x4 kvs = {0.f, 0.f, 0.f, 0.f};
#pragma unroll
        for (int j = 0; j < 16; ++j) kvs += *(const LAS f32x4*)(part + j * 128 + 4 * dvq);
        const f32x4 v4 = *(const LAS f32x4*)(cv + 256 + 4 * dvq);
        const f32x4 vnew = (v4 - kvs) * beta;
        f32x4 op = {0.f, 0.f, 0.f, 0.f};
        __syncthreads();
#pragma unroll
        for (int i = 0; i < 8; ++i) { const int dk = dkg + 16 * i; St[i] += vnew * (cv[128 + dk] * rk); *(f32x4*)(Sout + (size_t)dk * DH + 4 * dvq) = St[i]; op += St[i] * (cv[dk] * rq); }
        *(LAS f32x4*)(part + dkg * 128 + 4 * dvq) = op;
        __syncthreads();
        if (tid < 32) {
            f32x4 o = {0.f, 0.f, 0.f, 0.f};
#pragma unroll
            for (int j = 0; j < 16; ++j) o += *(const LAS f32x4*)(part + j * 128 + 4 * tid);
            float ss = o.x * o.x + o.y * o.y + o.z * o.z + o.w * o.w;
#pragma unroll
            for (int m = 1; m < 32; m <<= 1) ss += __shfl_xor(ss, m);
            const float rs = rsqrtf(ss * (1.f / DH) + EPS);
            const f32x4 nw = *(const f32x4*)(P.norm_a + l * DH + 4 * tid);
            const u32x2 zz = *(const u32x2*)(PROJ + (size_t)row * NIN + PC_ZA + h * DH + 4 * tid);
            u32x2 w; w.x = pk2(o.x * rs * nw.x * bflo(zz.x), o.y * rs * nw.y * bfhi(zz.x)); w.y = pk2(o.z * rs * nw.z * bflo(zz.y), o.w * rs * nw.w * bfhi(zz.y));
            *(u32x2*)(MIX + (size_t)row * DM + h * DH + 4 * tid) = w;
        }
        __syncthreads();
    }
    {
        const float* Sin = P.state_hgrn + sbase; float* Sout = P.out + OUT_HS + sbase;
        const u32x2 ib = *(const u32x2*)(PROJ + (size_t)row * NIN + PC_IB + h * DH + 4 * dvq);
        const f32x4 v4 = {bflo(ib.x), bfhi(ib.x), bflo(ib.y), bfhi(ib.y)};
        f32x4 op = {0.f, 0.f, 0.f, 0.f};
#pragma unroll
        for (int i = 0; i < 8; ++i) { const int dk = dkg + 16 * i; const float f = fq_[dk];
            const f32x4 sn = *(const f32x4*)(Sin + (size_t)dk * DH + 4 * dvq) * f + v4 * (1.f - f);
            *(f32x4*)(Sout + (size_t)dk * DH + 4 * dvq) = sn; op += sn * fq_[128 + dk]; }
        *(LAS f32x4*)(part + dkg * 128 + 4 * dvq) = op;
        __syncthreads();
        if (tid < 32) {
            f32x4 o = {0.f, 0.f, 0.f, 0.f};
#pragma unroll
            for (int j = 0; j < 16; ++j) o += *(const LAS f32x4*)(part + j * 128 + 4 * tid);
            float ss = o.x * o.x + o.y * o.y + o.z * o.z + o.w * o.w;
#pragma unroll
            for (int m = 1; m < 32; m <<= 1) ss += __shfl_xor(ss, m);
            const float rs = rsqrtf(ss * (1.f / DH) + EPS);
            const f32x4 nw = *(const f32x4*)(P.norm_b + l * DH + 4 * tid);
            const u32x2 zz = *(const u32x2*)(PROJ + (size_t)row * NIN + PC_OB + h * DH + 4 * tid);
            u32x2 w; w.x = pk2(o.x * rs * nw.x * bflo(zz.x), o.y * rs * nw.y * bfhi(zz.x)); w.y = pk2(o.z * rs * nw.z * bflo(zz.y), o.w * rs * nw.w * bfhi(zz.y));
            *(u32x2*)(MIX + (size_t)row * DM + 512 + h * DH + 4 * tid) = w;
        }
        __syncthreads();
    }
}

DI void phase_scan(const Params& P, int l, LAS unsigned char* lds) {
    const int G = gridDim.x, bid = blockIdx.x;
    const int step = (G > 64) ? (bid < 64 ? (1 << 30) : G - 64) : G;
    for (int j = bid; j < 64 + MS * NH; j += step) {
        if (j < 32) { scan_prompt<true>(P, l, j, lds);
#ifdef REP_SD
            scan_prompt<true>(P, l, j, lds);
#endif
        }
        else if (j < 64) scan_prompt<false>(P, l, j - 32, lds);
        else { sample_item(P, l, (j - 64) >> 2, (j - 64) & 3, lds);
#ifdef REP_SS
            sample_item(P, l, (j - 64) >> 2, (j - 64) & 3, lds);
#endif
        }
    }
    if (l == 0) { if (G > 64) { if (bid >= 64) phase0_rest(P, lds, bid - 64, G - 64); } else phase0_rest(P, lds, bid, G); }
}
DI bf16x8 gl_frag16(const bf16_t* p) { return *(const bf16x8*)p; }
template <int KIND, int KS, bool IN_F32 = false>
DI void sgemm_phase(const Params& P, int l, const bf16_t* A, const bf16_t* Bt, int N  , const void* xin_s, const float* gate, LAS unsigned char* lds, int first_blk = 0) {
    int tid_ = threadIdx.x; asm volatile("" : "+v"(tid_));
    const int tid = tid_, lane = tid & 63, wave = tid >> 6, fr = lane & 15, fq = lane >> 4;
    constexpr int NC = KIND == 0 ? 4 : 2, NACC = KIND == 1 ? 2 : 4, K = 256 * KS;
    const int ncg = N / (16 * NC), nunits = 8 * ncg;
    unsigned char* ws = P.ws;
    LAS f32x4* red = (LAS f32x4*)lds;
    if ((int)blockIdx.x < first_blk) return;
    for (int unit = blockIdx.x - first_blk; unit < nunits; unit += gridDim.x - first_blk) {
        const int rt = unit % 8, cg = unit / 8, n0 = cg * 16 * NC;
        f32x4 acc[NACC];
#pragma unroll
        for (int i = 0; i < NACC; ++i) acc[i] = (f32x4){0.f, 0.f, 0.f, 0.f};
        const bf16_t* ap = A + (size_t)(16 * rt + fr) * K + wave * (32 * KS) + 8 * fq;
        const bf16_t* bp[NC];
#pragma unroll
        for (int ct = 0; ct < NC; ++ct) { const int c = n0 + 16 * ct + fr; const int brow = KIND == 2 ? 256 * (c >> 7) + (c & 127) : c; bp[ct] = Bt + (size_t)brow * K + wave * (32 * KS) + 8 * fq; }
#pragma unroll
        for (int ks = 0; ks < KS; ++ks) {
            const bf16x8 a = gl_frag16(ap + 32 * ks);
#pragma unroll
            for (int ct = 0; ct < NC; ++ct) {
                acc[ct] = MFMA16(gl_frag16(bp[ct] + 32 * ks), a, acc[ct]);
                if (KIND == 2) acc[2 + ct] = MFMA16(gl_frag16(bp[ct] + (size_t)128 * K + 32 * ks), a, acc[2 + ct]);
            }
        }
#pragma unroll
        for (int i = 0; i < NACC; ++i) red[(wave * NACC + i) * 64 + lane] = acc[i];
        __syncthreads();
        if (wave < NC) {
            const int ct = wave;
            f32x4 s0 = (f32x4){0.f, 0.f, 0.f, 0.f}, s1 = (f32x4){0.f, 0.f, 0.f, 0.f};
#pragma unroll
            for (int w = 0; w < 8; ++w) { s0 += red[(w * NACC + ct) * 64 + lane]; if (KIND == 2) s1 += red[(w * NACC + 2 + ct) * 64 + lane]; }
            const int m = 16 * rt + fr, row = MP + m, col = n0 + 16 * ct + 4 * fq;
            if (KIND == 0) { const int tile = col >> 8; if (tile == 6 || tile == 7) { for (int j = 0; j < 4; ++j) s0[j] = siluf_(s0[j]); } else if (tile >= 14) { for (int j = 0; j < 4; ++j) s0[j] = sigmoidf_(s0[j]); }
                u32x2 o; o.x = pk2(s0[0], s0[1]); o.y = pk2(s0[2], s0[3]); *(u32x2*)((bf16_t*)(ws + WS_PROJ) + (size_t)row * NIN + col) = o; }
            else if (KIND == 1) { f32x4 xv; if (IN_F32) xv = *(const f32x4*)((const float*)xin_s + (size_t)m * DM + col); else { const u32x2 w = *(const u32x2*)((const bf16_t*)xin_s + (size_t)m * DM + col); xv = (f32x4){bflo(w.x), bfhi(w.x), bflo(w.y), bfhi(w.y)}; }
                const f32x4 gv = *(const f32x4*)(gate + (size_t)(NB + m) * NMOD + col); const f32x4 r = xv + gv * s0;
                u32x2 o; o.x = pk2(r.x, r.y); o.y = pk2(r.z, r.w); *(u32x2*)((bf16_t*)P.out + (size_t)row * DM + col) = o; }
            else { float r[4];
#pragma unroll
                for (int j = 0; j < 4; ++j) r[j] = siluf_(s0[j]) * s1[j];
                u32x2 o; o.x = pk2(r[0], r[1]); o.y = pk2(r[2], r[3]); *(u32x2*)((bf16_t*)(ws + WS_PROJ) + (size_t)row * DFF + col) = o; }
        }
        __syncthreads();
    }
}
#ifndef GEMM_SP2
#define GEMM_SP2 true
#endif
#ifndef GEMM_ALIGN
#define GEMM_ALIGN true
#endif
constexpr int NPHASE = 18;
#ifndef N_LAUNCH_MODE
#define N_LAUNCH_MODE 1
#endif

DI void run_phase(const Params& P, int ph, LAS unsigned char* lds) {
    unsigned char* ws = P.ws;
    const int G = gridDim.x;
    {
        if (ph == 0) phase0(P, lds);
        else {
            const int l = (ph - 1) >> 3, k = (ph - 1) & 7;
            bf16_t* H = (bf16_t*)(ws + WS_H);
            bf16_t* PROJ = (bf16_t*)(ws + WS_PROJ);
            const float* mods = (const float*)(ws + WS_MODS) + (size_t)l * MODROWS * NMOD;
            bf16_t* XB = (bf16_t*)P.out;
            if (k == 0) { if (l == 0) phase_norm<1>(P, 0, lds); else phase_norm<1>(P, 1, lds); }
            else if (k == 1) {
                pg8::Gemm g{H, (const bf16_t*)(ws + WS_WIN + l * SZ_WIN), MP, NIN, DM}; pg8::StaticOrder S; S.init(MP, NIN, G, (int)blockIdx.x);
                pg8::EpiProj E{PROJ, NIN};
                pg8::gemm_phase<pg8::EpiProj, pg8::StaticOrder, GEMM_ALIGN, GEMM_SP2>(lds, g, S, E);
                sgemm_phase<0, 4>(P, l, H + (size_t)MP * DM, (const bf16_t*)(ws + WS_WIN + l * SZ_WIN), NIN, nullptr, nullptr, lds);
            }
            else if (k == 2) phase_chunks(P, l, lds);
            else if (k == 3) phase_scan(P, l, lds);
            else if (k == 4) {
                pg8::Gemm g{H, (const bf16_t*)(ws + WS_WOUT + l * SZ_WOUT), MP, DM, DM}; pg8::StaticOrder S; S.init(MP, DM, G, (int)blockIdx.x);
                if (l == 0) { pg8::EpiRes<true> E{P.x_prompt, XB, mods + 2 * DM}; pg8::gemm_phase<pg8::EpiRes<true>, pg8::StaticOrder, GEMM_ALIGN, GEMM_SP2>(lds, g, S, E);
                    sgemm_phase<1, 4, true>(P, l, H + (size_t)MP * DM, (const bf16_t*)(ws + WS_WOUT + l * SZ_WOUT), DM, P.x_sample, mods + 2 * DM, lds); }
                else { pg8::EpiRes<false> E{XB, XB, mods + 2 * DM}; pg8::gemm_phase<pg8::EpiRes<false>, pg8::StaticOrder, GEMM_ALIGN, GEMM_SP2>(lds, g, S, E);
                    sgemm_phase<1, 4, false>(P, l, H + (size_t)MP * DM, (const bf16_t*)(ws + WS_WOUT + l * SZ_WOUT), DM, XB + (size_t)MP * DM, mods + 2 * DM, lds); }
            }
            else if (k == 5) phase_norm<2>(P, l, lds);
            else if (k == 6) {
                pg8::Gemm g{H, (const bf16_t*)(ws + WS_WGU + l * SZ_WGU), MP, NGU, DM}; pg8::StaticOrder S; S.init(MP, NGU, G, (int)blockIdx.x);
                pg8::EpiSwiGLU E{PROJ, DFF};
                pg8::gemm_phase<pg8::EpiSwiGLU, pg8::StaticOrder, GEMM_ALIGN, GEMM_SP2>(lds, g, S, E);
                sgemm_phase<2, 4>(P, l, H + (size_t)MP * DM, (const bf16_t*)(ws + WS_WGU + l * SZ_WGU), DFF, nullptr, nullptr, lds, ((MP / 256) * (NGU / 256)) % G);
            }
            else {
                pg8::Gemm g{PROJ, (const bf16_t*)(ws + WS_WDN + l * SZ_WDN), MP, DM, DFF}; pg8::StaticOrder S; S.init(MP, DM, G, (int)blockIdx.x);
                pg8::EpiRes<false> E{XB, XB, mods + 5 * DM};
                pg8::gemm_phase<pg8::EpiRes<false>, pg8::StaticOrder, GEMM_ALIGN, GEMM_SP2>(lds, g, S, E);
                sgemm_phase<1, 11, false>(P, l, PROJ + (size_t)MP * DFF, (const bf16_t*)(ws + WS_WDN + l * SZ_WDN), DM, XB + (size_t)MP * DM, mods + 5 * DM, lds);
            }
        }
    }
}

__global__ void __launch_bounds__(512, 2) fwd_kernel(Params P) {
    extern __shared__ __attribute__((aligned(16))) unsigned char lds_raw[];
    LAS unsigned char* lds = (LAS unsigned char*)lds_raw;
    cg::grid_group grid = cg::this_grid();
    unsigned char* ws = P.ws;
    XcdBarrier bar; bar.bar = (unsigned*)(ws + WS_BAR); bar.x = 0; bar.st = nullptr;
    if (P.ph_hi - P.ph_lo > 1) {
        volatile LAS unsigned* st = (volatile LAS unsigned*)(lds + LDS_MISC);
        if (threadIdx.x < 2) st[threadIdx.x] = 0u;
        __syncthreads();
        bar = xcd_barrier_post((unsigned*)(ws + WS_BAR), st);
    }
    for (int ph = P.ph_lo; ph < P.ph_hi; ++ph) {
        Params Q = P;
        size_t z0 = 0; asm volatile("" : "+s"(z0)); Q.ws = P.ws + z0; Q.out = P.out + z0;
        if (ph == NPHASE - 1) phase_final(Q, bar); else run_phase(Q, ph, lds);
#ifdef REP_MASK
        if ((REP_MASK >> ph) & 1) run_phase(Q, ph, lds);
#endif
#ifdef REP_BAR
        if (ph + 1 < P.ph_hi && ph > 0) { xcd_barrier(bar); }
#endif
        if (ph + 1 < P.ph_hi) { if (P.ph_lo < 0) { __threadfence(); grid.sync(); } else xcd_barrier(bar); }
    }
}

extern "C" void kernel_launch(void* const* d_in, const int* in_sizes, int n_in, void* d_out, int out_size, void* d_ws, size_t ws_size, hipStream_t stream) {
    static int grid = 0;
    if (grid == 0) {
        if (n_in != 23 || (size_t)out_size != OUT_END || ws_size < WS_END) { grid = -1; }
        else {
            int dev = 0, cus = 0, per_cu = 0;
            if (hipGetDevice(&dev) != hipSuccess || hipDeviceGetAttribute(&cus, hipDeviceAttributeMultiprocessorCount, dev) != hipSuccess) grid = -1;
            else if (hipFuncSetAttribute((const void*)fwd_kernel, hipFuncAttributeMaxDynamicSharedMemorySize, LDS_BYTES) != hipSuccess) grid = -1;
            else if (hipOccupancyMaxActiveBlocksPerMultiprocessor(&per_cu, (const void*)fwd_kernel, 512, LDS_BYTES) != hipSuccess || per_cu < 1) grid = -1;
            else if ((long)cus * 8 * FIN_ROWS < MT) grid = -1;
            else grid = cus;
        }
    }
    if (grid < 0) { (void)hipMemsetAsync(d_out, 0xFF, (size_t)out_size * 4, stream); return; }
    (void)hipMemsetAsync((unsigned char*)d_ws + WS_BAR, 0, 16384, stream);
    Params p{};
    p.x_prompt = (const float*)d_in[0]; p.x_sample = (const float*)d_in[1]; p.c_prompt = (const float*)d_in[2]; p.c_sample = (const float*)d_in[3];
    p.state_delta = (const float*)d_in[4]; p.state_conv = (const float*)d_in[5]; p.state_hgrn = (const float*)d_in[6];
    p.w_ada = (const float*)d_in[7]; p.b_ada = (const float*)d_in[8]; p.norm1 = (const float*)d_in[9]; p.w_in = (const float*)d_in[10];
    p.conv_w = (const float*)d_in[11]; p.a_log = (const float*)d_in[12]; p.dt_bias = (const float*)d_in[13]; p.norm_a = (const float*)d_in[14];
    p.norm_b = (const float*)d_in[15]; p.lb_logits = (const float*)d_in[16]; p.w_out = (const float*)d_in[17]; p.norm2 = (const float*)d_in[18];
    p.w_gate = (const float*)d_in[19]; p.w_up = (const float*)d_in[20]; p.w_down = (const float*)d_in[21]; p.norm_f = (const float*)d_in[22];
    p.out = (float*)d_out; p.ws = (unsigned char*)d_ws;
#if N_LAUNCH_MODE == 1
    p.ph_lo = 0; p.ph_hi = NPHASE;
    void* args[] = {&p};
    (void)hipLaunchCooperativeKernel((const void*)fwd_kernel, dim3(grid), dim3(512), args, LDS_BYTES, stream);
#else
    for (int ph = 0; ph < NPHASE; ++ph) { p.ph_lo = ph; p.ph_hi = ph + 1; hipLaunchKernelGGL(fwd_kernel, dim3(grid), dim3(512), LDS_BYTES, stream, p); }
#endif
}
```

```cpp
#include <hip/hip_runtime.h>
#include <hip/hip_cooperative_groups.h>
namespace cg = cooperative_groups;

#define LAS __attribute__((address_space(3)))
#define DI __device__ __forceinline__
typedef unsigned short bf16_t;
typedef short bf16x8 __attribute__((ext_vector_type(8)));
typedef short s16x4 __attribute__((ext_vector_type(4)));
typedef float f32x4 __attribute__((ext_vector_type(4)));
typedef float f32x2 __attribute__((ext_vector_type(2)));
typedef float f32x16 __attribute__((ext_vector_type(16)));
typedef unsigned u32x4 __attribute__((ext_vector_type(4)));
typedef unsigned u32x2 __attribute__((ext_vector_type(2)));
typedef __bf16 bf16x2_t __attribute__((ext_vector_type(2)));

constexpr int MP = 16384, MS = 128, MT = MP + MS, MPAD = 16640;
constexpr int DM = 1024, SEQ = 2048, NB = 8, NH = 4, DH = 128;
constexpr int INW = 4104, NIN = 4096, DFF = 2816, NGU = 5632, CONVD = 1536;
constexpr int NMOD = 6 * DM, MODROWS = NB + MS;
constexpr int NCH = 32, CH = 64;
constexpr float EPS = 1e-6f;
constexpr int PC_QA = 0, PC_KA = 512, PC_VA = 1024, PC_ZA = 1536, PC_QB = 2048, PC_FB = 2560, PC_IB = 3072, PC_OB = 3584;

constexpr size_t SZ_WIN = (size_t)NIN * DM * 2, SZ_WOUT = (size_t)DM * DM * 2, SZ_WGU = (size_t)NGU * DM * 2, SZ_WDN = (size_t)DM * DFF * 2;
constexpr size_t WS_WIN = 0;
constexpr size_t WS_WOUT = WS_WIN + 2 * SZ_WIN;
constexpr size_t WS_WGU = WS_WOUT + 2 * SZ_WOUT;
constexpr size_t WS_WDN = WS_WGU + 2 * SZ_WGU;
constexpr size_t WS_MODS = WS_WDN + 2 * SZ_WDN;
constexpr size_t WS_AB = WS_MODS + (size_t)2 * MODROWS * NMOD * 4;
constexpr size_t WS_LB = WS_AB + (size_t)MT * 8 * 4;
constexpr size_t WS_H = WS_LB + 4096;
constexpr size_t WS_PROJ = WS_H + (size_t)MPAD * DM * 2;
constexpr size_t DPACK_STRIDE = 77568, HPACK_STRIDE = 33280;
constexpr size_t WS_DPACK = WS_PROJ + (size_t)MPAD * NIN * 2;
constexpr size_t WS_HPACK = WS_DPACK + (size_t)1024 * DPACK_STRIDE;
constexpr size_t WS_BAR = WS_HPACK + (size_t)1024 * HPACK_STRIDE;
constexpr size_t WS_END = WS_BAR + 16384;
static_assert(WS_END <= (size_t)358000000, "workspace map");
static_assert(WS_WOUT % 256 == 0 && WS_WGU % 256 == 0 && WS_WDN % 256 == 0 && WS_MODS % 256 == 0 && WS_AB % 256 == 0 && WS_LB % 256 == 0 && WS_H % 256 == 0 && WS_PROJ % 256 == 0 && WS_DPACK % 256 == 0 && WS_HPACK % 256 == 0, "alignment");
constexpr int DP_NW = 0, DP_QD = 16896, DP_KDT = 33792, DP_UT = 51200, DP_QK = 68608, DP_GL = 77312, DP_BYTES = 77328;
constexpr int R128 = 264, R64 = 136;
constexpr size_t OUT_Y = 0;
constexpr size_t OUT_DP = (size_t)MT * DM;
constexpr size_t OUT_CP = OUT_DP + (size_t)2 * NB * NH * DH * DH;
constexpr size_t OUT_HP = OUT_CP + (size_t)2 * NB * 3 * CONVD;
constexpr size_t OUT_DS = OUT_HP + (size_t)2 * NB * NH * DH * DH;
constexpr size_t OUT_CS = OUT_DS + (size_t)2 * MS * NH * DH * DH;
constexpr size_t OUT_HS = OUT_CS + (size_t)2 * MS * 3 * CONVD;
constexpr size_t OUT_END = OUT_HS + (size_t)2 * MS * NH * DH * DH;

constexpr int LDS_BYTES = 147456;
constexpr int LDS_MISC = LDS_BYTES - 64;

DI unsigned pk2(float lo, float hi) { f32x2 v = {lo, hi}; bf16x2_t b = __builtin_convertvector(v, bf16x2_t); return __builtin_bit_cast(unsigned, b); }
DI unsigned short f2bf(float f) { return (unsigned short)(pk2(f, 0.f) & 0xffffu); }
DI float bf2f(unsigned short b) { return __uint_as_float(((unsigned)b) << 16); }
DI float bflo(unsigned w) { return __uint_as_float(w << 16); }
DI float bfhi(unsigned w) { return __uint_as_float(w & 0xffff0000u); }
DI float sigmoidf_(float x) { return __builtin_amdgcn_rcpf(1.f + __expf(-x)); }
DI float siluf_(float x) { return x * __builtin_amdgcn_rcpf(1.f + __expf(-x)); }
template <int CTRL> DI float dpp_(float x) { return __builtin_bit_cast(float, __builtin_amdgcn_mov_dpp(__builtin_bit_cast(int, x), CTRL, 0xf, 0xf, true)); }
DI float wave_sum(float v) {
    v += dpp_<0xB1>(v); v += dpp_<0x4E>(v); v += dpp_<0x141>(v); v += dpp_<0x128>(v);
    auto s = __builtin_amdgcn_permlane16_swap(__float_as_uint(v), __float_as_uint(v), false, false);
    v = __uint_as_float(s[0]) + __uint_as_float(s[1]);
    auto t = __builtin_amdgcn_permlane32_swap(__float_as_uint(v), __float_as_uint(v), false, false);
    return __uint_as_float(t[0]) + __uint_as_float(t[1]);
}
DI int modrow_of(int row) { return row < MP ? (row >> 11) : (NB + row - MP); }

struct Params {
    const float *x_prompt, *x_sample, *c_prompt, *c_sample, *state_delta, *state_conv, *state_hgrn;
    const float *w_ada, *b_ada, *norm1, *w_in, *conv_w, *a_log, *dt_bias, *norm_a, *norm_b, *lb_logits;
    const float *w_out, *norm2, *w_gate, *w_up, *w_down, *norm_f;
    float* out; unsigned char* ws;
    int ph_lo, ph_hi;
};
#define N_LAUNCH_MODE 1
namespace pg8 {
#define PG8_LAS __attribute__((address_space(3)))
typedef unsigned short bf16_t;
typedef short bf16x8 __attribute__((ext_vector_type(8)));
typedef float f32x4 __attribute__((ext_vector_type(4)));
typedef unsigned u32x4 __attribute__((ext_vector_type(4)));
constexpr int BM = 256, BK = 64, HALF = 128, HTB = HALF * BK * 2  , STAGE_BYTES = 8 * HTB, NXCD = 8, WGM = 8;

__host__ __device__ __forceinline__ int lds_byte(int r, int c) { const int st = (r >> 4) * 2 + (c >> 5), rr = r & 15, cc = c & 31, ob = rr * 64 + cc * 2; return st * 1024 + (ob ^ (((ob >> 9) & 1) << 5)); }
__host__ __device__ __forceinline__ void stage_rc(int b, int& R, int& C) { const int st = b / 1024, sb = b % 1024, swz = sb ^ (((sb >> 9) & 1) << 5); R = (st >> 1) * 16 + swz / 64; C = (st & 1) * 32 + (swz % 64) / 2; }
__host__ __device__ __forceinline__ int perm32(int rho) { const int n = rho >> 4, i = rho & 15; return 8 * (i >> 2) + 4 * n + (i & 3); }

struct Unit { int pm, pn; };
struct Gemm { const bf16_t* A; const bf16_t* Bt; int M, N, K; };

struct StaticOrder {
    int nM, nN, nwg, G, c;
    __host__ __device__ void init(int M, int N, int G_, int c_) { nM = M / BM; nN = N / BM; nwg = nM * nN; G = G_; c = c_; }
    __host__ __device__ bool next(int i, Unit& u) const {
        const long L = (long)i * G + c; if (L >= nwg) return false;
        int wgid = (int)L; { const int q = nwg / NXCD, r = nwg % NXCD, xcd = wgid % NXCD, off = wgid / NXCD; wgid = (xcd < r ? xcd * (q + 1) : r * (q + 1) + (xcd - r) * q) + off; }
        const int nig = WGM * nN, gid = wgid / nig, fm = gid * WGM, gsz = (nM - fm) < WGM ? (nM - fm) : WGM;
        u.pm = fm + ((wgid % nig) % gsz); u.pn = (wgid % nig) / gsz; return true;
    }
    __device__ __forceinline__ void a_ready(const Unit&) const {}
    __device__ __forceinline__ void done(const Unit&) const {}
};
__device__ __forceinline__ unsigned cvt_pk_bf16(float lo, float hi) { unsigned r; asm volatile("v_cvt_pk_bf16_f32 %0, %1, %2" : "=v"(r) : "v"(lo), "v"(hi)); return r; }
typedef float f32x2 __attribute__((ext_vector_type(2)));
struct EpiProj {
    static constexpr bool PERM = true, AFTER_DRAIN = false;
    bf16_t* O; int ldc;
    __device__ __forceinline__ void operator()(const f32x4 (&acc)[2][2][4][2], const Unit& u, int wr, int wc, int fr, int fq) const {
        const int row0 = u.pm * BM + wr * 64 + fr; const int col0 = u.pn * BM + wc * 32 + 8 * fq;
        const int kind = (u.pn == 6 || u.pn == 7) ? 1 : (u.pn >= 14 ? 2 : 0);
#pragma unroll
        for (int ai = 0; ai < 2; ++ai)
#pragma unroll
            for (int m = 0; m < 4; ++m) { bf16_t* rowp = O + (size_t)(row0 + ai * HALF + m * 16) * ldc + col0;
#pragma unroll
                for (int bj = 0; bj < 2; ++bj) { f32x4 v0 = acc[ai][bj][m][0], v1 = acc[ai][bj][m][1];
                    if (kind) {
#pragma unroll
                        for (int j = 0; j < 4; ++j) { const float s0 = __builtin_amdgcn_rcpf(1.f + __expf(-v0[j])), s1 = __builtin_amdgcn_rcpf(1.f + __expf(-v1[j])); v0[j] = kind == 1 ? v0[j] * s0 : s0; v1[j] = kind == 1 ? v1[j] * s1 : s1; } }
                    u32x4 w; w.x = ::pk2(v0[0], v0[1]); w.y = ::pk2(v0[2], v0[3]); w.z = ::pk2(v1[0], v1[1]); w.w = ::pk2(v1[2], v1[3]);
                    *(u32x4*)(rowp + bj * HALF) = w; } }
    }
};
struct EpiSwiGLU {
    static constexpr bool PERM = true, AFTER_DRAIN = false;
    bf16_t* O; int ldc;
    __device__ __forceinline__ void operator()(const f32x4 (&acc)[2][2][4][2], const Unit& u, int wr, int wc, int fr, int fq) const {
        const int row0 = u.pm * BM + wr * 64 + fr; const int col0 = u.pn * HALF + wc * 32 + 8 * fq;
#pragma unroll
        for (int ai = 0; ai < 2; ++ai)
#pragma unroll
            for (int m = 0; m < 4; ++m) { bf16_t* rowp = O + (size_t)(row0 + ai * HALF + m * 16) * ldc + col0;
                float r[8];
#pragma unroll
                for (int n = 0; n < 2; ++n)
#pragma unroll
                    for (int j = 0; j < 4; ++j) { const float g = acc[ai][0][m][n][j], up = acc[ai][1][m][n][j]; r[4 * n + j] = g * __builtin_amdgcn_rcpf(1.f + __expf(-g)) * up; }
                u32x4 w; w.x = ::pk2(r[0], r[1]); w.y = ::pk2(r[2], r[3]); w.z = ::pk2(r[4], r[5]); w.w = ::pk2(r[6], r[7]);
                *(u32x4*)rowp = w; }
    }
};
template <bool IN_F32> struct EpiRes {
    static constexpr bool PERM = false, AFTER_DRAIN = false;
    const void* xin; bf16_t* XB; const float* gate;
    __device__ __forceinline__ f32x4 ldx(size_t off) const {
        if (IN_F32) return *(const f32x4*)((const float*)xin + off);
        const u32x2 w = *(const u32x2*)((const bf16_t*)xin + off); return (f32x4){::bflo(w.x), ::bfhi(w.x), ::bflo(w.y), ::bfhi(w.y)};
    }
    __device__ __forceinline__ void operator()(const f32x4 (&acc)[2][2][4][2], const Unit& u, int wr, int wc, int fr, int fq) const {
        const int row0 = u.pm * BM + wr * 64 + fr, col0 = u.pn * BM + wc * 32 + 4 * fq;
        const float* gp = gate + (size_t)((u.pm * BM) >> 11) * ::NMOD + col0;
        f32x4 gv[2][2];
#pragma unroll
        for (int bj = 0; bj < 2; ++bj)
#pragma unroll
            for (int n = 0; n < 2; ++n) gv[bj][n] = *(const f32x4*)(gp + bj * HALF + n * 16);
        f32x4 xv[2][2][2];
#pragma unroll
        for (int bj = 0; bj < 2; ++bj)
#pragma unroll
            for (int n = 0; n < 2; ++n) xv[0][bj][n] = ldx((size_t)row0 * ::DM + col0 + bj * HALF + n * 16);
#pragma unroll
        for (int g = 0; g < 8; ++g) { const int ai = g >> 2, m = g & 3; const int row = row0 + ai * HALF + m * 16;
            if (g + 1 < 8) { const int nrow = row0 + ((g + 1) >> 2) * HALF + ((g + 1) & 3) * 16;
#pragma unroll
                for (int bj = 0; bj < 2; ++bj)
#pragma unroll
                    for (int n = 0; n < 2; ++n) xv[(g + 1) & 1][bj][n] = ldx((size_t)nrow * ::DM + col0 + bj * HALF + n * 16); }
            bf16_t* xo = XB + (size_t)row * ::DM + col0;
#pragma unroll
            for (int bj = 0; bj < 2; ++bj)
#pragma unroll
                for (int n = 0; n < 2; ++n) { const f32x4 r = xv[g & 1][bj][n] + gv[bj][n] * acc[ai][bj][m][n]; u32x2 o; o.x = ::pk2(r.x, r.y); o.y = ::pk2(r.z, r.w); *(u32x2*)(xo + bj * HALF + n * 16) = o; }
        }
    }
};
template <class Epi, class Sched, bool ALIGN_EPI = false, bool SP2 = false>
__device__ __forceinline__ void gemm_phase(PG8_LAS unsigned char* lds, const Gemm g, const Sched& S, const Epi& E) {
    int tid_ = threadIdx.x; asm volatile("" : "+v"(tid_));
    const int tid = tid_, wid = __builtin_amdgcn_readfirstlane(tid >> 6), lane = tid & 63, wr = wid >> 2, wc = wid & 3, fr = lane & 15, fq = lane >> 4;
    const int K = g.K, nt = K / BK;
    unsigned voffA[2], voffB[2];
#pragma unroll
    for (int i = 0; i < 2; ++i) { int R, C; stage_rc(tid * 16 + i * 8192, R, C); const int Rb = Epi::PERM ? ((R & ~31) + perm32(R & 31)) : R;
        voffA[i] = (unsigned)(R * K + C) * 2u; voffB[i] = (unsigned)(Rb * K + C) * 2u; }
    const size_t kstep = (size_t)(BK * 2);
    const size_t hstep = (size_t)HALF * K * 2;
    const size_t tstep = 2 * hstep;
    const unsigned ldsw = (unsigned)wid * 1024u;
    const int aoff = lds_byte(wr * 64 + fr, fq * 8), boff = lds_byte(wc * 32 + fr, fq * 8);
#define PG8_SA(b, h) (((b) * 2 + (h)) * HTB)
#define PG8_SB(b, h) ((4 + (b) * 2 + (h)) * HTB)
#define PG8_STAGE(bufoff, gbase, voff) do { _Pragma("unroll") for (int _i = 0; _i < 2; ++_i) \
        __builtin_amdgcn_global_load_lds((const unsigned*)((const char*)(gbase) + (voff)[_i]), (PG8_LAS unsigned*)(lds + (bufoff) + ldsw + _i * 8192), 16, 0, 0); } while (0)
#define PG8_LDA(dst, b, h) do { _Pragma("unroll") for (int m = 0; m < 4; ++m) _Pragma("unroll") for (int k = 0; k < 2; ++k) dst[m][k] = *(const PG8_LAS bf16x8*)(lds + PG8_SA(b, h) + aoff + m * 2048 + k * 1024); } while (0)
#define PG8_LDB(dst, b, h) do { _Pragma("unroll") for (int n = 0; n < 2; ++n) _Pragma("unroll") for (int k = 0; k < 2; ++k) dst[n][k] = *(const PG8_LAS bf16x8*)(lds + PG8_SB(b, h) + boff + n * 2048 + k * 1024); } while (0)
#define PG8_MMA(ai, bj, At, Bt) do { __builtin_amdgcn_s_setprio(1); _Pragma("unroll") for (int m = 0; m < 4; ++m) _Pragma("unroll") for (int n = 0; n < 2; ++n) _Pragma("unroll") for (int k = 0; k < 2; ++k) \
        acc[ai][bj][m][n] = __builtin_amdgcn_mfma_f32_16x16x32_bf16(Bt[n][k], At[m][k], acc[ai][bj][m][n], 0, 0, 0); __builtin_amdgcn_s_setprio(0); } while (0)
#define PG8_WAIT_V(n) asm volatile("s_waitcnt vmcnt(" #n ")" ::: "memory")
#define PG8_WAIT_L(n) asm volatile("s_waitcnt lgkmcnt(" #n ")" ::: "memory")
#define PG8_BAR __builtin_amdgcn_s_barrier()
#define PG8_SCHED __builtin_amdgcn_sched_barrier(0)
    Unit cur, nxt; int ui = 0;
    if (!S.next(0, cur)) return;
    f32x4 acc[2][2][4][2];
#pragma unroll
    for (int a = 0; a < 2; ++a)
#pragma unroll
        for (int b = 0; b < 2; ++b)
#pragma unroll
            for (int m = 0; m < 4; ++m)
#pragma unroll
                for (int n = 0; n < 2; ++n) acc[a][b][m][n] = (f32x4){0.f, 0.f, 0.f, 0.f};
    bf16x8 At[4][2], B0[2][2], B1[2][2];
    const char* cA = (const char*)g.A + (size_t)cur.pm * tstep; const char* cB = (const char*)g.Bt + (size_t)cur.pn * tstep;
    S.a_ready(cur);
    if constexpr (SP2) {
        PG8_STAGE(PG8_SB(0, 0), cB, voffB); PG8_STAGE(PG8_SB(0, 1), cB + hstep, voffB); PG8_STAGE(PG8_SA(0, 0), cA, voffA); PG8_STAGE(PG8_SA(0, 1), cA + hstep, voffA);
        if (wr == 1) PG8_BAR;
        PG8_WAIT_V(2); PG8_BAR;
        PG8_STAGE(PG8_SB(1, 0), cB + kstep, voffB); PG8_STAGE(PG8_SA(1, 0), cA + kstep, voffA); PG8_STAGE(PG8_SB(1, 1), cB + hstep + kstep, voffB);
        PG8_WAIT_V(6); PG8_BAR;
    } else {
        PG8_STAGE(PG8_SB(0, 0), cB, voffB); PG8_STAGE(PG8_SA(0, 0), cA, voffA); PG8_STAGE(PG8_SB(0, 1), cB + hstep, voffB); PG8_STAGE(PG8_SA(0, 1), cA + hstep, voffA);
        if (wr == 1) PG8_BAR;
        PG8_WAIT_V(4); PG8_BAR;
        PG8_STAGE(PG8_SB(1, 0), cB + kstep, voffB); PG8_STAGE(PG8_SA(1, 0), cA + kstep, voffA); PG8_STAGE(PG8_SB(1, 1), cB + hstep + kstep, voffB);
        PG8_WAIT_V(6); PG8_BAR;
    }
    for (;;) {
        const bool has_next = S.next(ui + 1, nxt);
        const char* nA = has_next ? (const char*)g.A + (size_t)nxt.pm * tstep : cA; const char* nB = has_next ? (const char*)g.Bt + (size_t)nxt.pn * tstep : cB;
        for (int t = 0; t < nt; t += 2) {
            const bool last = (t == nt - 2);
            const char* a1 = cA + (size_t)(t + 1) * kstep;
            const char* a2 = last ? nA : cA + (size_t)(t + 2) * kstep; const char* b2 = last ? nB : cB + (size_t)(t + 2) * kstep;
            const char* a3 = a2 + kstep; const char* b3 = b2 + kstep;
            if (last && has_next) S.a_ready(nxt);
            if constexpr (SP2) {
            PG8_LDB(B0, 0, 0); PG8_LDB(B1, 0, 1); PG8_SCHED; PG8_LDA(At, 0, 0); PG8_STAGE(PG8_SA(1, 1), a1 + hstep, voffA);
            PG8_WAIT_V(8); PG8_WAIT_L(0); PG8_BAR; PG8_MMA(0, 0, At, B0); PG8_MMA(0, 1, At, B1); PG8_BAR; PG8_SCHED;
            PG8_LDA(At, 0, 1); PG8_STAGE(PG8_SB(0, 0), b2, voffB); PG8_STAGE(PG8_SB(0, 1), b2 + hstep, voffB); PG8_STAGE(PG8_SA(0, 0), a2, voffA);
            PG8_WAIT_V(8); PG8_WAIT_L(0); PG8_BAR; PG8_MMA(1, 0, At, B0); PG8_MMA(1, 1, At, B1); PG8_BAR; PG8_SCHED;
            PG8_LDB(B0, 1, 0); PG8_LDB(B1, 1, 1); PG8_SCHED; PG8_LDA(At, 1, 0); PG8_STAGE(PG8_SA(0, 1), a2 + hstep, voffA);
            PG8_WAIT_V(8); PG8_WAIT_L(0); PG8_BAR; PG8_MMA(0, 0, At, B0); PG8_MMA(0, 1, At, B1); PG8_BAR; PG8_SCHED;
            PG8_LDA(At, 1, 1); PG8_STAGE(PG8_SB(1, 0), b3, voffB); PG8_STAGE(PG8_SB(1, 1), b3 + hstep, voffB); PG8_STAGE(PG8_SA(1, 0), a3, voffA);
            PG8_WAIT_V(8); PG8_WAIT_L(0); PG8_BAR; PG8_MMA(1, 0, At, B0); PG8_MMA(1, 1, At, B1); PG8_BAR; PG8_SCHED;
            } else {
            PG8_LDB(B0, 0, 0); PG8_SCHED; PG8_LDA(At, 0, 0); PG8_STAGE(PG8_SA(1, 1), a1 + hstep, voffA);
            PG8_WAIT_L(8); PG8_BAR; PG8_WAIT_L(0); PG8_MMA(0, 0, At, B0); PG8_BAR; PG8_SCHED;
            PG8_LDB(B1, 0, 1); PG8_STAGE(PG8_SB(0, 0), b2, voffB);
            PG8_BAR; PG8_WAIT_L(0); PG8_MMA(0, 1, At, B1); PG8_BAR;
            PG8_LDA(At, 0, 1); PG8_STAGE(PG8_SA(0, 0), a2, voffA);
            PG8_BAR; PG8_WAIT_L(0); PG8_MMA(1, 0, At, B0); PG8_BAR; PG8_SCHED;
            PG8_STAGE(PG8_SB(0, 1), b2 + hstep, voffB);
            PG8_WAIT_V(6); PG8_BAR; PG8_MMA(1, 1, At, B1); PG8_BAR;
            PG8_LDB(B0, 1, 0); PG8_SCHED; PG8_LDA(At, 1, 0); PG8_STAGE(PG8_SA(0, 1), a2 + hstep, voffA);
            PG8_WAIT_L(8); PG8_BAR; PG8_WAIT_L(0); PG8_MMA(0, 0, At, B0); PG8_BAR; PG8_SCHED;
            PG8_LDB(B1, 1, 1); PG8_STAGE(PG8_SB(1, 0), b3, voffB);
            PG8_BAR; PG8_WAIT_L(0); PG8_MMA(0, 1, At, B1); PG8_BAR;
            PG8_LDA(At, 1, 1); PG8_STAGE(PG8_SA(1, 0), a3, voffA);
            PG8_BAR; PG8_WAIT_L(0); PG8_MMA(1, 0, At, B0); PG8_BAR; PG8_SCHED;
            PG8_STAGE(PG8_SB(1, 1), b3 + hstep, voffB);
            PG8_WAIT_V(6); PG8_BAR; PG8_MMA(1, 1, At, B1); PG8_BAR;
            }
        }
        if constexpr (ALIGN_EPI) { if (wr == 0) PG8_BAR; }
        if constexpr (!Epi::AFTER_DRAIN) { E(acc, cur, wr, wc, fr, fq); S.done(cur); }
        if (!has_next) break;
#pragma unroll
        for (int a = 0; a < 2; ++a)
#pragma unroll
            for (int b = 0; b < 2; ++b)
#pragma unroll
                for (int m = 0; m < 4; ++m)
#pragma unroll
                    for (int n = 0; n < 2; ++n) acc[a][b][m][n] = (f32x4){0.f, 0.f, 0.f, 0.f};
        cur = nxt; cA = nA; cB = nB; ++ui;
        if constexpr (ALIGN_EPI) { if (wr == 1) PG8_BAR; }
    }
    PG8_WAIT_V(0);
    if constexpr (!ALIGN_EPI) { if (wr == 0) PG8_BAR; }
    PG8_BAR;
    if constexpr (Epi::AFTER_DRAIN) { E.fused(acc, cur, wr, wc, fr, fq, lds, wid, lane); S.done(cur); }
#undef PG8_SA
#undef PG8_SB
#undef PG8_STAGE
#undef PG8_LDA
#undef PG8_LDB
#undef PG8_MMA
#undef PG8_WAIT_V
#undef PG8_WAIT_L
#undef PG8_BAR
#undef PG8_SCHED
}
}


#define XB_TMO      128
#define XB_XCNT(j)  (256  + 64 * (j))
#define XB_XSUB(j)  (1280 + 64 * (j))
#define XB_XGEN(j)  (2304 + 64 * (j))
#define XB_TOP      3328
#define XB_TOPGEN   3392
#define XCD_BAR_WORDS 3456
#define XB_SPIN_CAP (1u << 18)

__device__ __forceinline__ unsigned xb_ld(unsigned* p)              { return __hip_atomic_load(p, __ATOMIC_RELAXED, __HIP_MEMORY_SCOPE_AGENT); }
__device__ __forceinline__ unsigned xb_add(unsigned* p, unsigned v) { return __hip_atomic_fetch_add(p, v, __ATOMIC_RELAXED, __HIP_MEMORY_SCOPE_AGENT); }
__device__ __forceinline__ unsigned xb_xcc_id() { return (unsigned)__builtin_amdgcn_s_getreg((3 << 11) | 20) & 0xFu; }
#define XB_SPIN(cond, bar) do { unsigned _sp = 0; while (cond) { __builtin_amdgcn_s_sleep(1); \
    if ((++_sp & 255u) == 0u) { if (xb_ld(&(bar)[XB_TMO])) break; if (_sp > XB_SPIN_CAP) { atomicAdd(&(bar)[XB_TMO], 1u); break; } } } } while (0)

struct XcdBarrier {
    unsigned* bar; unsigned x;
    volatile LAS unsigned* st;
};

__device__ __forceinline__ XcdBarrier xcd_barrier_post(unsigned* bar, volatile LAS unsigned* st) {
    XcdBarrier b; b.bar = bar; b.x = xb_xcc_id(); b.st = st;
    if (threadIdx.x == 0) (void)xb_add(&bar[XB_XCNT(b.x)], 1u);
    return b;
}
__device__ __forceinline__ void xcd_barrier_complete(unsigned* bar, unsigned x, unsigned& nloc, unsigned& nx) {
    const unsigned G = gridDim.x * gridDim.y * gridDim.z;
    unsigned sum, cnt, mine, sp = 0u;
    for (;;) {
        sum = 0u; cnt = 0u; mine = 0u;
#pragma unroll
        for (unsigned j = 0; j < 16; ++j) { const unsigned c = xb_ld(&bar[XB_XCNT(j)]); sum += c; cnt += (c > 0u) ? 1u : 0u; mine = (j == x) ? c : mine; }
        if (sum == G) break;
        __builtin_amdgcn_s_sleep(1);
        if ((++sp & 255u) == 0u) { if (xb_ld(&bar[XB_TMO])) break; if (sp > XB_SPIN_CAP) { atomicAdd(&bar[XB_TMO], 1u); break; } }
    }
    nloc = mine > 0u ? mine : 1u; nx = cnt > 0u ? cnt : 1u;
}

__device__ __forceinline__ void xcd_barrier(const XcdBarrier& b) {
    asm volatile("s_waitcnt vmcnt(0)" ::: "memory");
    __syncthreads();
    if (threadIdx.x == 0) {
        unsigned* bar = b.bar;
        __builtin_amdgcn_s_waitcnt(0);
        unsigned nloc = b.st[0], nx = b.st[1];
        if (nloc == 0u) { xcd_barrier_complete(bar, b.x, nloc, nx); b.st[0] = nloc; b.st[1] = nx; }
        const unsigned old = xb_add(&bar[XB_XSUB(b.x)], 1u);
        const unsigned gen = old / nloc;
        if (old + 1u == (gen + 1u) * nloc) {
            __builtin_amdgcn_fence(__ATOMIC_RELEASE, "agent");
            asm volatile("s_waitcnt vmcnt(0)" ::: "memory");
            const unsigned og = xb_add(&bar[XB_TOP], 1u);
            const unsigned tg = og / nx;
            if (og + 1u == (tg + 1u) * nx) xb_add(&bar[XB_TOPGEN], 1u);
            else XB_SPIN(xb_ld(&bar[XB_TOPGEN]) == tg, bar);
            __builtin_amdgcn_fence(__ATOMIC_ACQUIRE, "agent");
            xb_add(&bar[XB_XGEN(b.x)], 1u);
            asm volatile("s_waitcnt vmcnt(0)" ::: "memory");
        } else {
            XB_SPIN(xb_ld(&bar[XB_XGEN(b.x)]) == gen, bar);
            __builtin_amdgcn_fence(__ATOMIC_ACQUIRE, "agent");
            asm volatile("s_waitcnt vmcnt(0)" ::: "memory");
        }
    }
    __syncthreads();
}
DI void transpose_item(const float* W, int ldw, int srccol0, int k0, bf16_t* WT, int ldk, int dstrow0, LAS float* scr, int lane) {
#pragma unroll
    for (int i = 0; i < 32; ++i) { const int kk = 2 * i + (lane >> 5); scr[kk * 33 + (lane & 31)] = W[(size_t)(k0 + kk) * ldw + srccol0 + (lane & 31)]; }
    asm volatile("s_waitcnt lgkmcnt(0)" ::: "memory");
    const int c = lane & 7;
#pragma unroll
    for (int j = 0; j < 4; ++j) { const int n = (lane >> 3) + 8 * j; const LAS float* s = scr + (8 * c) * 33 + n;
        u32x4 o; o.x = pk2(s[0 * 33], s[1 * 33]); o.y = pk2(s[2 * 33], s[3 * 33]); o.z = pk2(s[4 * 33], s[5 * 33]); o.w = pk2(s[6 * 33], s[7 * 33]);
        *(u32x4*)(WT + (size_t)(dstrow0 + n) * ldk + k0 + 8 * c) = o; }
    asm volatile("s_waitcnt lgkmcnt(0)" ::: "memory");
}

DI void prologue_work(const Params& P, LAS unsigned char* lds, int wk, int nwork, int it_lo, int it_hi, int slab_lo, int slab_hi, bool do_lb) {
    int tid_ = threadIdx.x; asm volatile("" : "+v"(tid_));
    const int tid = tid_, lane = tid & 63, wave = tid >> 6, G = nwork, bid = wk;
    unsigned char* ws = P.ws;
    {
        LAS float* scr = (LAS float*)(lds + wave * 16384);
        constexpr int I_IN = 16 * 128, I_OUT = 16 * 32, I_G = 16 * 88, I_D = 44 * 32, I_L = I_IN + I_OUT + 2 * I_G + I_D;
        const int gw = bid * 8 + wave, NGW = G * 8;
        for (int it = it_lo + gw; it < it_hi; it += NGW) {
            const int l = it / I_L; int r = it % I_L;
            if (r < I_IN) { const int kb = r / 128, nb = r % 128, n0 = 32 * nb;
                transpose_item(P.w_in + (size_t)l * DM * INW, INW, n0 < 2048 ? n0 : n0 + 8, 64 * kb, (bf16_t*)(ws + WS_WIN + l * SZ_WIN), DM, n0, scr, lane); continue; }
            r -= I_IN;
            if (r < I_OUT) { const int kb = r / 32, nb = r % 32;
                transpose_item(P.w_out + (size_t)l * DM * DM, DM, 32 * nb, 64 * kb, (bf16_t*)(ws + WS_WOUT + l * SZ_WOUT), DM, 32 * nb, scr, lane); continue; }
            r -= I_OUT;
            if (r < 2 * I_G) { const int up = r / I_G; r %= I_G; const int kb = r / 88, nb = r % 88, n0 = 32 * nb;
                transpose_item((up ? P.w_up : P.w_gate) + (size_t)l * DM * DFF, DFF, n0, 64 * kb, (bf16_t*)(ws + WS_WGU + l * SZ_WGU), DM, 256 * (n0 >> 7) + 128 * up + (n0 & 127), scr, lane); continue; }
            r -= 2 * I_G;
            { const int kb = r / 32, nb = r % 32;
                transpose_item(P.w_down + (size_t)l * DFF * DM, DM, 32 * nb, 64 * kb, (bf16_t*)(ws + WS_WDN + l * SZ_WDN), DFF, 32 * nb, scr, lane); }
        }
    }
    if (do_lb && bid == 0) {
        float* lb = (float*)(ws + WS_LB);
        for (int j = tid; j < 512; j += 512) { const float a = P.lb_logits[j], b = P.lb_logits[512 + j]; const float m = fmaxf(a, b); const float ea = expf(a - m), eb = expf(b - m);
            lb[j] = 0.f; lb[512 + j] = eb / (ea + eb); }
    }
    __syncthreads();
    {
        constexpr int M_AHI = 0, M_ALO = 144 * 272, M_BHI = 2 * 144 * 272, M_BLO = M_BHI + 48 * 272;
        float* mods = (float*)(ws + WS_MODS);
        const int fr = lane & 15, fq = lane >> 4;
        for (int e = tid; e < 8 * 136 / 2; e += 512) { ((LAS unsigned*)(lds + M_AHI + 136 * 272))[e] = 0u; ((LAS unsigned*)(lds + M_ALO + 136 * 272))[e] = 0u; }
        for (int slab = slab_lo + bid; slab < slab_hi; slab += G) {
            const int l = slab >> 7, n0 = (slab & 127) * 48;
            f32x4 acc[4];
#pragma unroll
            for (int i = 0; i < 4; ++i) acc[i] = (f32x4){0.f, 0.f, 0.f, 0.f};
            float wreg[12]; f32x4 creg[9];
#define MODS_LOAD(kc_) do { int tidl = tid; asm volatile("" : "+v"(tidl));     \
                _Pragma("unroll") for (int i = 0; i < 12; ++i) { const int e = tidl + 512 * i; const int k = e / 48, c = e % 48; wreg[i] = P.w_ada[((size_t)l * DM + (kc_) * 128 + k) * NMOD + n0 + c]; } \
                _Pragma("unroll") for (int i = 0; i < 9; ++i) { const int e = tidl + 512 * i; if (i < 8 || e < MODROWS * 32) { const int row = e >> 5, k4 = e & 31; \
                    creg[i] = *(const f32x4*)((row < NB ? P.c_prompt + (size_t)row * DM : P.c_sample + (size_t)(row - NB) * DM) + (kc_) * 128 + 4 * k4); } } } while (0)
            MODS_LOAD(0);
            for (int kc = 0; kc < 8; ++kc) {
                __syncthreads();
#pragma unroll
                for (int i = 0; i < 12; ++i) { const int e = tid + 512 * i; const int k = e / 48, c = e % 48; const float w = wreg[i];
                    const unsigned short hi = f2bf(w); *(LAS unsigned short*)(lds + M_BHI + c * 272 + 2 * k) = hi; *(LAS unsigned short*)(lds + M_BLO + c * 272 + 2 * k) = f2bf(w - bf2f(hi)); }
#pragma unroll
                for (int i = 0; i < 9; ++i) { const int e = tid + 512 * i; if (i < 8 || e < MODROWS * 32) { const int row = e >> 5, k4 = e & 31;
                    f32x4 v = creg[i]; v.x = siluf_(v.x); v.y = siluf_(v.y); v.z = siluf_(v.z); v.w = siluf_(v.w);
                    u32x2 h; h.x = pk2(v.x, v.y); h.y = pk2(v.z, v.w);
                    u32x2 lo; lo.x = pk2(v.x - bflo(h.x), v.y - bfhi(h.x)); lo.y = pk2(v.z - bflo(h.y), v.w - bfhi(h.y));
                    *(LAS u32x2*)(lds + M_AHI + row * 272 + 8 * k4) = h; *(LAS u32x2*)(lds + M_ALO + row * 272 + 8 * k4) = lo; } }
                __syncthreads();
                if (kc + 1 < 8) MODS_LOAD(kc + 1);
#pragma unroll
                for (int i = 0; i < 4; ++i) { const int t = wave + 8 * i;
                    if (t < 27) { const int rt = t / 3, ct = t % 3;
#pragma unroll
                        for (int ks = 0; ks < 4; ++ks) {
                            const bf16x8 ah = *(const LAS bf16x8*)(lds + M_AHI + (16 * rt + fr) * 272 + (32 * ks + 8 * fq) * 2), al = *(const LAS bf16x8*)(lds + M_ALO + (16 * rt + fr) * 272 + (32 * ks + 8 * fq) * 2);
                            const bf16x8 bh = *(const LAS bf16x8*)(lds + M_BHI + (16 * ct + fr) * 272 + (32 * ks + 8 * fq) * 2), bl = *(const LAS bf16x8*)(lds + M_BLO + (16 * ct + fr) * 272 + (32 * ks + 8 * fq) * 2);
                            acc[i] = __builtin_amdgcn_mfma_f32_16x16x32_bf16(ah, bh, acc[i], 0, 0, 0);
                            acc[i] = __builtin_amdgcn_mfma_f32_16x16x32_bf16(ah, bl, acc[i], 0, 0, 0);
                            acc[i] = __builtin_amdgcn_mfma_f32_16x16x32_bf16(al, bh, acc[i], 0, 0, 0);
                        } } }
            }
#pragma unroll
            for (int i = 0; i < 4; ++i) { const int t = wave + 8 * i;
                if (t < 27) { const int rt = t / 3, ct = t % 3; const int col = n0 + 16 * ct + fr; const float bb = P.b_ada[(size_t)l * NMOD + col];
#pragma unroll
                    for (int jj = 0; jj < 4; ++jj) { const int row = 16 * rt + 4 * fq + jj; if (row < MODROWS) mods[((size_t)l * MODROWS + row) * NMOD + col] = acc[i][jj] + bb; } } }
        }
#undef MODS_LOAD
    }
}

constexpr int P0_I_IN = 16 * 128, P0_I_ALL = 2 * (16 * 128 + 16 * 32 + 2 * 16 * 88 + 44 * 32);
DI void phase0(const Params& P, LAS unsigned char* lds) { prologue_work(P, lds, blockIdx.x, gridDim.x, 0, P0_I_IN, 0, 256, true); }
DI void phase0_rest(const Params& P, LAS unsigned char* lds, int wk, int nwork) { __syncthreads(); prologue_work(P, lds, wk, nwork, P0_I_IN, P0_I_ALL, 256, 256, false); }

template <int WHICH>
DI void phase_norm(const Params& P, int l, LAS unsigned char* lds) {
    int tid_ = threadIdx.x; asm volatile("" : "+v"(tid_));
    const int tid = tid_, lane = tid & 63, wave = tid >> 6, G = gridDim.x, bid = blockIdx.x;
    unsigned char* ws = P.ws;
    LAS float* wab = (LAS float*)lds;
    if (WHICH == 1) {
#pragma unroll
        for (int i = 0; i < 16; ++i) { const int e = tid + 512 * i; wab[e] = P.w_in[((size_t)l * DM + (e >> 3)) * INW + 2048 + (e & 7)]; }
        __syncthreads();
    }
    const bf16_t* XB = (const bf16_t*)P.out;
    const float* mods = (const float*)(ws + WS_MODS) + (size_t)l * MODROWS * NMOD;
    const float* nw = (WHICH == 1 ? P.norm1 : P.norm2) + (size_t)l * DM;
    constexpr int SHIFT = WHICH == 1 ? 0 : 3 * DM, SCALE = WHICH == 1 ? DM : 4 * DM;
    bf16_t* H = (bf16_t*)(ws + WS_H);
    float* AB = (float*)(ws + WS_AB);
#define NORM_LOADROW(row_, dst_) do { if (WHICH == 1 && l == 0) { const float* xr_ = (row_) < MP ? P.x_prompt + (size_t)(row_) * DM : P.x_sample + (size_t)((row_) - MP) * DM; \
            _Pragma("unroll") for (int j = 0; j < 4; ++j) dst_[j] = *(const f32x4*)(xr_ + 4 * (lane + 64 * j)); } \
        else { const bf16_t* xr_ = XB + (size_t)(row_) * DM; \
            _Pragma("unroll") for (int j = 0; j < 4; ++j) { const u32x2 w_ = *(const u32x2*)(xr_ + 4 * (lane + 64 * j)); dst_[j] = (f32x4){bflo(w_.x), bfhi(w_.x), bflo(w_.y), bfhi(w_.y)}; } } } while (0)
    f32x4 vn[3][4];
#pragma unroll
    for (int q = 0; q < 3; ++q) { const int rowq = bid * 8 + wave + q * G * 8; if (rowq < MT) NORM_LOADROW(rowq, vn[q]); }
    for (int row = bid * 8 + wave; row < MT; row += G * 8) {
        const float* mr = mods + (size_t)modrow_of(row) * NMOD;
        f32x4 v[4]; float ss = 0.f;
#pragma unroll
        for (int j = 0; j < 4; ++j) { v[j] = vn[0][j]; vn[0][j] = vn[1][j]; vn[1][j] = vn[2][j]; }
        { const int nrow = row + 3 * G * 8; if (nrow < MT) NORM_LOADROW(nrow, vn[2]); }
#pragma unroll
        for (int j = 0; j < 4; ++j) ss += v[j].x * v[j].x + v[j].y * v[j].y + v[j].z * v[j].z + v[j].w * v[j].w;
        const float rs = rsqrtf(wave_sum(ss) * (1.f / DM) + EPS);
        float ab[8];
#pragma unroll
        for (int e = 0; e < 8; ++e) ab[e] = 0.f;
#pragma unroll
        for (int j = 0; j < 4; ++j) { const int col = 4 * (lane + 64 * j);
            const f32x4 w4 = *(const f32x4*)(nw + col), sc = *(const f32x4*)(mr + SCALE + col), sh = *(const f32x4*)(mr + SHIFT + col);
            f32x4 h = v[j] * rs * w4 * (sc + 1.f) + sh;
            u32x2 o; o.x = pk2(h.x, h.y); o.y = pk2(h.z, h.w);
            *(u32x2*)(H + (size_t)row * DM + col) = o;
            if (WHICH == 1) {
#pragma unroll
                for (int e = 0; e < 4; ++e) { const f32x4 a = *(const LAS f32x4*)(wab + (col + e) * 8), b = *(const LAS f32x4*)(wab + (col + e) * 8 + 4); const float hv = h[e];
                    ab[0] += hv * a.x; ab[1] += hv * a.y; ab[2] += hv * a.z; ab[3] += hv * a.w; ab[4] += hv * b.x; ab[5] += hv * b.y; ab[6] += hv * b.z; ab[7] += hv * b.w; }
            }
        }
        if (WHICH == 1) {
#pragma unroll
            for (int e = 0; e < 8; ++e) ab[e] = wave_sum(ab[e]);
            if (lane == 0) { *(f32x4*)(AB + (size_t)row * 8) = (f32x4){ab[0], ab[1], ab[2], ab[3]}; *(f32x4*)(AB + (size_t)row * 8 + 4) = (f32x4){ab[4], ab[5], ab[6], ab[7]}; }
        }
    }
}

DI void phase_final(const Params& P) {
    int tid_ = threadIdx.x; asm volatile("" : "+v"(tid_));
    const int tid = tid_, lane = tid & 63, wave = tid >> 6, G = gridDim.x, bid = blockIdx.x;
    const bf16_t* XS = (const bf16_t*)(P.ws + WS_H); float* Y = P.out;
    u32x2 xn[3][4];
#define FIN_LOAD(row_, dst_) do { _Pragma("unroll") for (int j = 0; j < 4; ++j) dst_[j] = *(const u32x2*)(XS + (size_t)(row_) * DM + 4 * (lane + 64 * j)); } while (0)
#pragma unroll
    for (int q = 0; q < 3; ++q) { const int rowq = bid * 8 + wave + q * G * 8; if (rowq < MT) FIN_LOAD(rowq, xn[q]); }
    f32x4 w4[4];
#pragma unroll
    for (int j = 0; j < 4; ++j) w4[j] = *(const f32x4*)(P.norm_f + 4 * (lane + 64 * j));
    for (int row = bid * 8 + wave; row < MT; row += G * 8) {
        u32x2 x[4];
#pragma unroll
        for (int j = 0; j < 4; ++j) { x[j] = xn[0][j]; xn[0][j] = xn[1][j]; xn[1][j] = xn[2][j]; }
        { const int nrow = row + 3 * G * 8; if (nrow < MT) FIN_LOAD(nrow, xn[2]); }
        f32x4 v[4]; float ss = 0.f;
#pragma unroll
        for (int j = 0; j < 4; ++j) { v[j] = (f32x4){bflo(x[j].x), bfhi(x[j].x), bflo(x[j].y), bfhi(x[j].y)}; ss += v[j].x * v[j].x + v[j].y * v[j].y + v[j].z * v[j].z + v[j].w * v[j].w; }
        const float rs = rsqrtf(wave_sum(ss) * (1.f / DM) + EPS);
#pragma unroll
        for (int j = 0; j < 4; ++j) *(f32x4*)(Y + (size_t)row * DM + 4 * (lane + 64 * j)) = v[j] * rs * w4[j];
    }
#undef FIN_LOAD
}
#define MFMA16(a, b, c) __builtin_amdgcn_mfma_f32_16x16x32_bf16((a), (b), (c), 0, 0, 0)
#define MFMA32(a, b, c) __builtin_amdgcn_mfma_f32_32x32x16_bf16((a), (b), (c), 0, 0, 0)
DI bf16x8 lds_frag16(const LAS unsigned char* p) { return *(const LAS bf16x8*)p; }

constexpr int CD_SCAL = 0;
constexpr int CD_A = 1024;
constexpr int CD_TB = CD_A + 64 * 272;
constexpr int CD_QN = CD_TB + 64 * 144;
constexpr int CD_KN = CD_QN + 64 * 272;
constexpr int CD_VBT = CD_KN + 64 * 272;
constexpr int CD_KBGT = CD_VBT + 128 * 144;
constexpr int CD_KDT = CD_KBGT + 128 * 144;
constexpr int CD_END = CD_KDT + 128 * 136;
static_assert(CD_END <= LDS_BYTES, "phase C delta LDS");
constexpr int CH_TOT = 0;
constexpr int CH_QH = 2048;
constexpr int CH_KH = CH_QH + 64 * 272;
constexpr int CH_KTT = CH_KH + 160 * 272;
constexpr int CH_VT = CH_KTT + 128 * 144;
constexpr int CH_AB = CH_VT + 128 * 144;
constexpr int CH_END = CH_AB + 64 * 144;
static_assert(CH_END <= LDS_BYTES, "phase C hgrn LDS");

struct DeltaIn { unsigned xr[3][11]; float aa, ba; };
DI void delta_load(const Params& P, int b, int h, int c, DeltaIn& in) {
    int tid_ = threadIdx.x; asm volatile("" : "+v"(tid_));
    const int lane = tid_ & 63, t0 = (tid_ >> 6) * 8;
    const bf16_t* PROJ = (const bf16_t*)(P.ws + WS_PROJ);
    const float* AB = (const float*)(P.ws + WS_AB);
    const int R0 = b * SEQ + c * CH;
#pragma unroll
    for (int m = 0; m < 3; ++m)
#pragma unroll
        for (int j = 0; j < 11; ++j) { const int t = t0 - 3 + j; in.xr[m][j] = (c > 0 || t >= 0) ? *(const unsigned*)(PROJ + (size_t)(R0 + t) * NIN + m * 512 + h * DH + 2 * lane) : 0u; }
    in.aa = AB[(size_t)(R0 + lane) * 8 + h]; in.ba = AB[(size_t)(R0 + lane) * 8 + 4 + h];
}
DI void chunk_delta(const Params& P, int l, int b, int h, int c, LAS unsigned char* lds, const DeltaIn& in) {
    int tid_ = threadIdx.x; asm volatile("" : "+v"(tid_));
    const int tid = tid_, lane = tid & 63, wave = tid >> 6;
    unsigned char* ws = P.ws;
    const int R0 = b * SEQ + c * CH;
    unsigned char* pack = ws + WS_DPACK + (size_t)((b * NH + h) * NCH + c) * DPACK_STRIDE;
    LAS float* scal = (LAS float*)(lds + CD_SCAL);
    const int t0 = wave * 8;
    if (wave == 0) {
        const float aa = in.aa, ba = in.ba;
        const float xx = aa + P.dt_bias[l * NH + h];
        const float sp = xx > 20.f ? xx : log1pf(expf(xx));
        float g = -expf(P.a_log[l * NH + h]) * sp;
        const float beta = 1.f / (1.f + expf(-ba));
        float Gc = g;
#pragma unroll
        for (int o = 1; o < 64; o <<= 1) { const float t = __shfl_up(Gc, o); if (lane >= o) Gc += t; }
        const float Gl = __shfl(Gc, 63);
        scal[lane] = beta; scal[64 + lane] = Gc; scal[128 + lane] = expf(Gc); scal[192 + lane] = expf(Gl - Gc);
        if (lane == 0) *(float*)(pack + DP_GL) = expf(Gl);
    }
    __syncthreads();
    {
        const float* cw = P.conv_w + (size_t)l * 4 * CONVD;
#pragma unroll
        for (int m = 0; m < 3; ++m) {
            const int chan = m * 512 + h * DH + 2 * lane;
            f32x2 w[4];
#pragma unroll
            for (int j = 0; j < 4; ++j) w[j] = *(const f32x2*)(cw + j * CONVD + chan);
#pragma unroll
            for (int tt = 0; tt < 8; ++tt) {
                const int t = t0 + tt;
                const f32x2 x0 = {bflo(in.xr[m][tt]), bfhi(in.xr[m][tt])}, x1 = {bflo(in.xr[m][tt + 1]), bfhi(in.xr[m][tt + 1])}, x2 = {bflo(in.xr[m][tt + 2]), bfhi(in.xr[m][tt + 2])}, x3 = {bflo(in.xr[m][tt + 3]), bfhi(in.xr[m][tt + 3])};
                f32x2 y = x0 * w[0] + x1 * w[1] + x2 * w[2] + x3 * w[3];
                y.x = siluf_(y.x); y.y = siluf_(y.y);
                if (c == NCH - 1 && t >= CH - 3) *(f32x2*)(P.out + OUT_CP + ((size_t)(l * NB + b) * 3 + (t - (CH - 3))) * CONVD + chan) = x3;
                const float beta = scal[t], eG = scal[128 + t], eGl = scal[192 + t];
                if (m == 0) {
                    const float rs = rsqrtf(wave_sum(y.x * y.x + y.y * y.y) + EPS) * 0.08838834764831845f;
                    y = y * rs;
                    *(LAS unsigned*)(lds + CD_QN + t * 272 + 4 * lane) = pk2(y.x, y.y);
                    *(unsigned*)(pack + DP_QD + t * R128 + 4 * lane) = pk2(y.x * eG, y.y * eG);
                } else if (m == 1) {
                    const float rs = rsqrtf(wave_sum(y.x * y.x + y.y * y.y) + EPS);
                    y = y * rs;
                    *(LAS unsigned*)(lds + CD_KN + t * 272 + 4 * lane) = pk2(y.x, y.y);
                    const float s1 = beta * eG;
                    *(LAS unsigned short*)(lds + CD_KBGT + (2 * lane) * 144 + 2 * t) = f2bf(y.x * s1);
                    *(LAS unsigned short*)(lds + CD_KBGT + (2 * lane + 1) * 144 + 2 * t) = f2bf(y.y * s1);
                    *(LAS unsigned short*)(lds + CD_KDT + (2 * lane) * 136 + 2 * t) = f2bf(y.x * eGl);
                    *(LAS unsigned short*)(lds + CD_KDT + (2 * lane + 1) * 136 + 2 * t) = f2bf(y.y * eGl);
                } else {
                    *(LAS unsigned short*)(lds + CD_VBT + (2 * lane) * 144 + 2 * t) = f2bf(y.x * beta);
                    *(LAS unsigned short*)(lds + CD_VBT + (2 * lane + 1) * 144 + 2 * t) = f2bf(y.y * beta);
                }
            }
        }
    }
    __syncthreads();
    {
        const int fr = lane & 15, fq = lane >> 4;
#pragma unroll
        for (int e = 0; e < 2; ++e) {
            const int ti = (2 * wave + e) >> 2, tj = (2 * wave + e) & 3;
            f32x4 acc = {0.f, 0.f, 0.f, 0.f};
            if (tj <= ti) {
#pragma unroll
                for (int ks = 0; ks < 4; ++ks) {
                    const bf16x8 a = lds_frag16(lds + CD_KN + (16 * tj + fr) * 272 + (32 * ks + 8 * fq) * 2);
                    const bf16x8 bq = lds_frag16(lds + CD_QN + (16 * ti + fr) * 272 + (32 * ks + 8 * fq) * 2);
                    acc = MFMA16(a, bq, acc);
                }
            }
            {
                const int i = 16 * ti + fr; const float Gi = scal[64 + i]; float r[4];
#pragma unroll
                for (int jj = 0; jj < 4; ++jj) { const int j = 16 * tj + 4 * fq + jj; r[jj] = (j <= i) ? acc[jj] * __expf(Gi - scal[64 + j]) : 0.f; }
                u32x2 o; o.x = pk2(r[0], r[1]); o.y = pk2(r[2], r[3]);
                *(u32x2*)(pack + DP_QK + i * R64 + (16 * tj + 4 * fq) * 2) = o;
            }
            if (tj <= ti) {
                f32x4 acc2 = {0.f, 0.f, 0.f, 0.f};
#pragma unroll
                for (int ks = 0; ks < 4; ++ks) {
                    const bf16x8 a = lds_frag16(lds + CD_KN + (16 * ti + fr) * 272 + (32 * ks + 8 * fq) * 2);
                    const bf16x8 bk = lds_frag16(lds + CD_KN + (16 * tj + fr) * 272 + (32 * ks + 8 * fq) * 2);
                    acc2 = MFMA16(a, bk, acc2);
                }
                const int j = 16 * tj + fr; const float Gj = scal[64 + j];
#pragma unroll
                for (int jj = 0; jj < 4; ++jj) { const int i = 16 * ti + 4 * fq + jj;
                    *(LAS float*)(lds + CD_A + (i * 68 + j) * 4) = (j < i) ? scal[i] * acc2[jj] * __expf(scal[64 + i] - Gj) : 0.f; }
            }
        }
    }
    __syncthreads();
    {
        const LAS float* A = (const LAS float*)(lds + CD_A);
        LAS float* Xl = (LAS float*)(lds + CD_QN);
        LAS float* Wl = (LAS float*)(lds + CD_KN) + wave * 256;
        const int fr = lane & 15, fq = lane >> 4;
        if (wave == 0) {
            const int blk = fq, cc = fr;
            const LAS float* Ab = A + (16 * blk) * 68 + 16 * blk;
            float tc[16];
#pragma unroll
            for (int i = 0; i < 16; ++i) {
                float a0 = (i == cc) ? 1.f : 0.f, a1 = 0.f;
#pragma unroll
                for (int j = 0; j < i; ++j) { const float p = Ab[i * 68 + j] * tc[j]; if (j & 1) a1 -= p; else a0 -= p; }
                tc[i] = a0 + a1;
            }
#pragma unroll
            for (int i = 0; i < 16; ++i) Xl[(16 * blk + i) * 68 + 16 * blk + cc] = tc[i];
        } else {
            for (int e = tid - 64; e < 128 * 136 / 16; e += 448) *(u32x4*)(pack + DP_KDT + e * 16) = *(const LAS u32x4*)(lds + CD_KDT + e * 16);
        }
        __syncthreads();
#pragma unroll
        for (int d = 1; d < 4; ++d) {
            if (wave < 4 - d) {
                const int b = d + wave, cb = wave;
                f32x4 w = {0.f, 0.f, 0.f, 0.f};
#pragma unroll
                for (int kk = 0; kk < d; ++kk) { const int k = cb + kk;
#pragma unroll
                    for (int s4 = 0; s4 < 4; ++s4)
                        w = __builtin_amdgcn_mfma_f32_16x16x4f32(A[(16 * b + fr) * 68 + 16 * k + 4 * s4 + fq], Xl[(16 * k + 4 * s4 + fq) * 68 + 16 * cb + fr], w, 0, 0, 0);
                }
#pragma unroll
                for (int r4 = 0; r4 < 4; ++r4) Wl[(4 * fq + r4) * 16 + fr] = w[r4];
                f32x4 x2 = {0.f, 0.f, 0.f, 0.f};
#pragma unroll
                for (int s4 = 0; s4 < 4; ++s4)
                    x2 = __builtin_amdgcn_mfma_f32_16x16x4f32(Xl[(16 * b + fr) * 68 + 16 * b + 4 * s4 + fq], Wl[(4 * s4 + fq) * 16 + fr], x2, 0, 0, 0);
#pragma unroll
                for (int r4 = 0; r4 < 4; ++r4) Xl[(16 * b + 4 * fq + r4) * 68 + 16 * cb + fr] = -x2[r4];
            }
            __syncthreads();
        }
        {
            const int i = tid >> 3, j0 = (tid & 7) * 8;
            u32x4 o = {0u, 0u, 0u, 0u};
            if ((j0 >> 4) <= (i >> 4)) { const f32x4 x0 = *(const LAS f32x4*)(Xl + i * 68 + j0), x1 = *(const LAS f32x4*)(Xl + i * 68 + j0 + 4);
                o.x = pk2(x0.x, x0.y); o.y = pk2(x0.z, x0.w); o.z = pk2(x1.x, x1.y); o.w = pk2(x1.z, x1.w); }
            *(LAS u32x4*)(lds + CD_TB + i * 144 + 2 * j0) = o;
        }
    }
    __syncthreads();
    {
        const int fr = lane & 15, fq = lane >> 4;
        const int ti = wave >> 1;
        bf16x8 ta[2];
#pragma unroll
        for (int ks = 0; ks < 2; ++ks) ta[ks] = lds_frag16(lds + CD_TB + (16 * ti + fr) * 144 + (32 * ks + 8 * fq) * 2);
#pragma unroll
        for (int e = 0; e < 4; ++e) {
            const int tv = 4 * (wave & 1) + e;
            f32x4 acc = {0.f, 0.f, 0.f, 0.f};
#pragma unroll
            for (int ks = 0; ks < 2; ++ks) acc = MFMA16(ta[ks], lds_frag16(lds + CD_VBT + (16 * tv + fr) * 144 + (32 * ks + 8 * fq) * 2), acc);
            u32x2 o; o.x = pk2(acc[0], acc[1]); o.y = pk2(acc[2], acc[3]);
            *(u32x2*)(pack + DP_UT + (16 * tv + fr) * R64 + (16 * ti + 4 * fq) * 2) = o;
        }
        bf16x8 ka[2];
#pragma unroll
        for (int ks = 0; ks < 2; ++ks) ka[ks] = lds_frag16(lds + CD_KBGT + (16 * wave + fr) * 144 + (32 * ks + 8 * fq) * 2);
#pragma unroll
        for (int ti2 = 0; ti2 < 4; ++ti2) {
            f32x4 acc = {0.f, 0.f, 0.f, 0.f};
#pragma unroll
            for (int ks = 0; ks < 2; ++ks) acc = MFMA16(ka[ks], lds_frag16(lds + CD_TB + (16 * ti2 + fr) * 144 + (32 * ks + 8 * fq) * 2), acc);
            u32x2 o; o.x = pk2(-acc[0], -acc[1]); o.y = pk2(-acc[2], -acc[3]);
            *(u32x2*)(pack + DP_NW + (16 * ti2 + fr) * R128 + (16 * wave + 4 * fq) * 2) = o;
        }
    }
    __syncthreads();
}

struct HgrnIn { unsigned short fb[16], qb[16], ib[16]; };
DI void hgrn_load(const Params& P, int b, int h, int c, HgrnIn& in) {
    int tid_ = threadIdx.x; asm volatile("" : "+v"(tid_));
    const int dk = tid_ & 127, a = tid_ >> 7;
    const bf16_t* PROJ = (const bf16_t*)(P.ws + WS_PROJ);
    const int R0 = b * SEQ + c * CH;
#pragma unroll
    for (int i = 0; i < 16; ++i) { const size_t ro = (size_t)(R0 + 16 * a + i) * NIN + h * DH + dk; in.fb[i] = PROJ[ro + PC_FB]; in.qb[i] = PROJ[ro + PC_QB]; in.ib[i] = PROJ[ro + PC_IB]; }
}
template <bool DRY>
DI void chunk_hgrn(const Params& P, int l, int b, int h, int c, LAS unsigned char* lds, const HgrnIn& in) {
    int tid_ = threadIdx.x; asm volatile("" : "+v"(tid_));
    const int tid = tid_, lane = tid & 63, wave = tid >> 6;
    unsigned char* ws = P.ws;
    bf16_t* PROJ = (bf16_t*)(ws + WS_PROJ);
    bf16_t* MIX = (bf16_t*)(ws + WS_H);
    const int R0 = b * SEQ + c * CH;
    unsigned char* hp = ws + WS_HPACK + (size_t)((b * NH + h) * NCH + c) * HPACK_STRIDE;
    LAS float* tot = (LAS float*)(lds + CH_TOT);
    {
        const int dk = tid & 127, a = tid >> 7;
        const float lbv = ((const float*)(ws + WS_LB))[l * 512 + h * DH + dk];
        float kk[16], qq[16], gl[16]; float run = 0.f;
#pragma unroll
        for (int i = 0; i < 16; ++i) {
            const float fb = bf2f(in.fb[i]), qb = bf2f(in.qb[i]);
            const float f = lbv + (1.f - lbv) * sigmoidf_(fb);
            run += __logf(f);
            gl[i] = run; kk[i] = 1.f - f; qq[i] = siluf_(qb);
        }
        tot[a * 128 + dk] = run;
        __syncthreads();
        float G0[5]; G0[0] = 0.f;
#pragma unroll
        for (int x = 0; x < 4; ++x) G0[x + 1] = G0[x] + tot[x * 128 + dk];
        const float g0a = a == 0 ? G0[0] : a == 1 ? G0[1] : a == 2 ? G0[2] : G0[3];
        const float gtot = G0[4];
        if (a == 0) *(float*)(hp + 32768 + 4 * dk) = __expf(gtot);
        const float eg0 = __expf(g0a);
        unsigned kt[8];
#pragma unroll
        for (int i = 0; i < 16; ++i) {
            const int t = 16 * a + i;
            const float qh = qq[i] * __expf(gl[i]);
            *(LAS unsigned short*)(lds + CH_QH + t * 272 + 2 * dk) = f2bf(qh);
            if (!DRY) PROJ[(size_t)(R0 + t) * NIN + PC_QB + h * DH + dk] = f2bf(qh * eg0);
#pragma unroll
            for (int ap = 0; ap < 4; ++ap) {
                if (ap >= a) {
                    const float ex = fminf(G0[ap] - g0a - gl[i], 80.f);
                    const int rowbase = ap == 0 ? 0 : ap == 1 ? 16 : ap == 2 ? 48 : 96;
                    *(LAS unsigned short*)(lds + CH_KH + (rowbase + t) * 272 + 2 * dk) = f2bf(kk[i] * __expf(ex));
                }
            }
            const float ktv = kk[i] * __expf(gtot - g0a - gl[i]);
            if (i & 1) kt[i >> 1] |= ((unsigned)f2bf(ktv)) << 16; else kt[i >> 1] = f2bf(ktv);
        }
        *(LAS u32x4*)(lds + CH_KTT + dk * 144 + 32 * a) = (u32x4){kt[0], kt[1], kt[2], kt[3]};
        *(LAS u32x4*)(lds + CH_KTT + dk * 144 + 32 * a + 16) = (u32x4){kt[4], kt[5], kt[6], kt[7]};
        unsigned vt[8];
#pragma unroll
        for (int i = 0; i < 16; ++i) { const unsigned short u = in.ib[i]; if (i & 1) vt[i >> 1] |= ((unsigned)u) << 16; else vt[i >> 1] = u; }
        *(LAS u32x4*)(lds + CH_VT + dk * 144 + 32 * a) = (u32x4){vt[0], vt[1], vt[2], vt[3]};
        *(LAS u32x4*)(lds + CH_VT + dk * 144 + 32 * a + 16) = (u32x4){vt[4], vt[5], vt[6], vt[7]};
    }
    __syncthreads();
    const int fr = lane & 15, fq = lane >> 4;
#pragma unroll
    for (int e = 0; e < 2; ++e) {
        const int a = (wave + 8 * e) >> 2, bb = (wave + 8 * e) & 3;
        f32x4 acc = {0.f, 0.f, 0.f, 0.f};
        if (bb <= a) {
            const int rowbase = a == 0 ? 0 : a == 1 ? 16 : a == 2 ? 48 : 96;
#pragma unroll
            for (int ks = 0; ks < 4; ++ks)
                acc = MFMA16(lds_frag16(lds + CH_QH + (16 * a + fr) * 272 + (32 * ks + 8 * fq) * 2), lds_frag16(lds + CH_KH + (rowbase + 16 * bb + fr) * 272 + (32 * ks + 8 * fq) * 2), acc);
        }
#pragma unroll
        for (int jj = 0; jj < 4; ++jj) { const int i = 16 * a + 4 * fq + jj, j = 16 * bb + fr;
            *(LAS unsigned short*)(lds + CH_AB + i * 144 + 2 * j) = f2bf(j <= i ? acc[jj] : 0.f); }
    }
    __syncthreads();
    {
        bf16x8 va[2];
#pragma unroll
        for (int ks = 0; ks < 2; ++ks) va[ks] = lds_frag16(lds + CH_VT + (16 * wave + fr) * 144 + (32 * ks + 8 * fq) * 2);
#pragma unroll
        for (int ti = 0; ti < 4; ++ti) {
            f32x4 acc = {0.f, 0.f, 0.f, 0.f};
#pragma unroll
            for (int ks = 0; ks < 2; ++ks) acc = MFMA16(va[ks], lds_frag16(lds + CH_AB + (16 * ti + fr) * 144 + (32 * ks + 8 * fq) * 2), acc);
            u32x2 o; o.x = pk2(acc[0], acc[1]); o.y = pk2(acc[2], acc[3]);
            if (!DRY) *(u32x2*)(MIX + (size_t)(R0 + 16 * ti + fr) * DM + 512 + h * DH + 16 * wave + 4 * fq) = o;
        }
        bf16x8 ka[2];
#pragma unroll
        for (int ks = 0; ks < 2; ++ks) ka[ks] = lds_frag16(lds + CH_KTT + (16 * wave + fr) * 144 + (32 * ks + 8 * fq) * 2);
        unsigned* img = (unsigned*)hp;
#pragma unroll
        for (int tv = 0; tv < 8; ++tv) {
            f32x4 acc = {0.f, 0.f, 0.f, 0.f};
#pragma unroll
            for (int ks = 0; ks < 2; ++ks) acc = MFMA16(ka[ks], lds_frag16(lds + CH_VT + (16 * tv + fr) * 144 + (32 * ks + 8 * fq) * 2), acc);
            const int a32 = wave >> 1, hh = fq & 1, p0 = 4 * (wave & 1) + 2 * (fq >> 1);
            const int dv = 16 * tv + fr, w = dv >> 5, r = dv & 31;
            img[((w * 4 + a32) * 8 + p0) * 64 + hh * 32 + r] = pk2(acc[0], acc[1]);
            img[((w * 4 + a32) * 8 + p0 + 1) * 64 + hh * 32 + r] = pk2(acc[2], acc[3]);
        }
    }
    __syncthreads();
}

DI void phase_chunks(const Params& P, int l, LAS unsigned char* lds) {
    DeltaIn din;
    { const int item = blockIdx.x; if (item < NB * NH * NCH) delta_load(P, item >> 7, (item >> 5) & 3, item & 31, din); }
    for (int item = blockIdx.x; item < NB * NH * NCH; item += gridDim.x) {
        const int c = item & 31, h = (item >> 5) & 3, b = item >> 7;
        HgrnIn hin; hgrn_load(P, b, h, c, hin);
        chunk_delta(P, l, b, h, c, lds, din);
#ifdef REP_CD
        chunk_delta(P, l, b, h, c, lds, din);
#endif
        { const int nitem = item + gridDim.x; if (nitem < NB * NH * NCH) delta_load(P, nitem >> 7, (nitem >> 5) & 3, nitem & 31, din); }
#ifdef REP_CH
        chunk_hgrn<true>(P, l, b, h, c, lds, hin);
#endif
        chunk_hgrn<false>(P, l, b, h, c, lds, hin);
    }
}
constexpr int SS_BLOC = 34816;
constexpr int SS_OBUF = 77568, SS_OBUF_SZ = 64 * 132 * 4, SS_DVEC = SS_OBUF + 2 * SS_OBUF_SZ, SS_END = SS_DVEC + 512;
static_assert(SS_END <= LDS_MISC, "scan LDS");

DI bf16x8 pack_acc(const f32x16& x, int s) {
    u32x4 p;
    p.x = pk2(x[8 * s + 0], x[8 * s + 1]); p.y = pk2(x[8 * s + 2], x[8 * s + 3]); p.z = pk2(x[8 * s + 4], x[8 * s + 5]); p.w = pk2(x[8 * s + 6], x[8 * s + 7]);
    return __builtin_bit_cast(bf16x8, p);
}
DI bf16x8 lds_frag32(const LAS unsigned char* rowp, int e0) {
    const u32x2 lo = *(const LAS u32x2*)(rowp + 2 * e0), hi = *(const LAS u32x2*)(rowp + 2 * e0 + 16);
    u32x4 p = {lo.x, lo.y, hi.x, hi.y};
    return __builtin_bit_cast(bf16x8, p);
}

#define BAR_LDS() do { asm volatile("s_waitcnt lgkmcnt(0)" ::: "memory"); __builtin_amdgcn_s_barrier(); asm volatile("" ::: "memory"); } while (0)
template <bool DELTA>
DI void scan_prompt(const Params& P, int l, int bh, LAS unsigned char* lds) {
    int tid_ = threadIdx.x; asm volatile("" : "+v"(tid_));
    const int tid = tid_, lane = tid & 63, wave = __builtin_amdgcn_readfirstlane(tid >> 6);
    const int r = lane & 31, hh = lane >> 5;
    unsigned char* ws = P.ws;
    const int b = bh >> 2, h = bh & 3;
    const bf16_t* PROJ = (const bf16_t*)(ws + WS_PROJ);
    bf16_t* MIX = (bf16_t*)(ws + WS_H);
    LAS float* obuf = (LAS float*)(lds + SS_OBUF);
    LAS float* dvec = (LAS float*)(lds + SS_DVEC);
    const float* normw = (DELTA ? P.norm_a : P.norm_b) + l * DH;
    __syncthreads();
    if (DELTA) {
        const unsigned char* pack = ws + WS_DPACK + (size_t)(bh * NCH) * DPACK_STRIDE;
        for (int e = tid; e < DP_BYTES / 16; e += 512) *(LAS u32x4*)(lds + e * 16) = *(const u32x4*)(pack + e * 16);
    } else {
        const unsigned char* hp = ws + WS_HPACK + (size_t)(bh * NCH) * HPACK_STRIDE;
        for (int e = tid; e < 64 * 16; e += 512) { const u32x4 v = *(const u32x4*)(PROJ + (size_t)(b * SEQ + (e >> 4)) * NIN + PC_QB + h * DH + (e & 15) * 8);
            LAS unsigned char* d = lds + DP_QD + (e >> 4) * R128 + (e & 15) * 16; *(LAS u32x2*)d = (u32x2){v.x, v.y}; *(LAS u32x2*)(d + 8) = (u32x2){v.z, v.w}; }
        for (int e = tid; e < 2048; e += 512) *(LAS u32x4*)(lds + SS_BLOC + e * 16) = *(const u32x4*)(hp + e * 16);
        if (tid < 128) dvec[tid] = *(const float*)(hp + 32768 + 4 * tid);
    }
#define SCAN_PREFETCH(c_, gz_, ol_) do { const int R0_ = b * SEQ + (c_) * CH; int lane = lane0; asm volatile("" : "+v"(lane)); \
        _Pragma("unroll") for (int p_ = 0; p_ < 2; ++p_) { const int t = (wave - 4) * 16 + 8 * p_ + (lane >> 3); \
            const bf16_t* gp_ = PROJ + (size_t)(R0_ + t) * NIN + (DELTA ? PC_ZA : PC_OB) + h * DH + 16 * (lane & 7); \
            gz_[2 * p_] = *(const u32x4*)gp_; gz_[2 * p_ + 1] = *(const u32x4*)(gp_ + 8); \
            if (!DELTA) { const bf16_t* op_ = MIX + (size_t)(R0_ + t) * DM + 512 + h * DH + 16 * (lane & 7); ol_[2 * p_] = *(const u32x4*)op_; ol_[2 * p_ + 1] = *(const u32x4*)(op_ + 8); } } } while (0)
#define SCAN_FINISH(c_, gz_, ol_) do { const int R0_ = b * SEQ + (c_) * CH; int lane = lane0; asm volatile("" : "+v"(lane)); \
        const LAS float* ob_ = (const LAS float*)(lds + SS_OBUF + ((c_) & 1) * SS_OBUF_SZ); \
        _Pragma("unroll") for (int p_ = 0; p_ < 2; ++p_) { const int t = (wave - 4) * 16 + 8 * p_ + (lane >> 3); \
            float o_[16]; \
            _Pragma("unroll") for (int q_ = 0; q_ < 4; ++q_) { const f32x4 v_ = *(const LAS f32x4*)(ob_ + t * 132 + 16 * (lane & 7) + 4 * q_); o_[4 * q_] = v_.x; o_[4 * q_ + 1] = v_.y; o_[4 * q_ + 2] = v_.z; o_[4 * q_ + 3] = v_.w; } \
            if (!DELTA) { _Pragma("unroll") for (int q_ = 0; q_ < 8; ++q_) { const unsigned w_ = ol_[2 * p_ + (q_ >> 2)][q_ & 3]; o_[2 * q_] += bflo(w_); o_[2 * q_ + 1] += bfhi(w_); } } \
            float ss_ = 0.f; \
            _Pragma("unroll") for (int q_ = 0; q_ < 16; ++q_) ss_ += o_[q_] * o_[q_]; \
            ss_ += dpp_<0xB1>(ss_); ss_ += dpp_<0x4E>(ss_); ss_ += dpp_<0x141>(ss_); \
            const float rs_ = rsqrtf(ss_ * (1.f / DH) + EPS); \
            unsigned pk_[8]; \
            _Pragma("unroll") for (int q_ = 0; q_ < 8; ++q_) { const unsigned w_ = gz_[2 * p_ + (q_ >> 2)][q_ & 3]; \
                pk_[q_] = pk2(o_[2 * q_] * rs_ * nwv[2 * q_] * bflo(w_), o_[2 * q_ + 1] * rs_ * nwv[2 * q_ + 1] * bfhi(w_)); } \
            bf16_t* mp_ = MIX + (size_t)(R0_ + t) * DM + (DELTA ? 0 : 512) + h * DH + 16 * (lane & 7); \
            *(u32x4*)mp_ = (u32x4){pk_[0], pk_[1], pk_[2], pk_[3]}; *(u32x4*)(mp_ + 8) = (u32x4){pk_[4], pk_[5], pk_[6], pk_[7]}; } } while (0)
    if (wave < 4) {
        const int dv0 = 32 * wave;
        f32x16 S[4];
#pragma unroll
        for (int a = 0; a < 4; ++a)
#pragma unroll
            for (int i = 0; i < 16; ++i) S[a][i] = 0.f;
        for (int c = 0; c < NCH; ++c) {
            BAR_LDS();
            bf16x8 Spk[4][2];
#pragma unroll
            for (int a = 0; a < 4; ++a)
#pragma unroll
                for (int s = 0; s < 2; ++s) Spk[a][s] = pack_acc(S[a], s);
            f32x16 O[2], V[2]; bf16x8 Vpk[2][2];
#pragma unroll
            for (int mt = 0; mt < 2; ++mt)
#pragma unroll
                for (int i = 0; i < 16; ++i) O[mt][i] = 0.f;
            constexpr int NG = DELTA ? 14 : 4;
            bf16x8 fb[2][4];
#define LOAD_GROUP(g_, f_) do { \
                _Pragma("unroll") for (int i_ = 0; i_ < 4; ++i_) { \
                    if ((g_) < 8) f_[i_] = lds_frag32(lds + ((g_) < 4 ? DP_QD : DP_NW) + (32 * (i_ & 1) + r) * R128 + 64 * ((g_) & 3), 16 * (i_ >> 1) + 4 * hh); \
                    else if ((g_) < 10) { if ((g_) == 8 || (i_ & 1)) f_[i_] = lds_frag32(lds + DP_QK + (32 * (i_ & 1) + r) * R64 + 64 * ((g_) - 8), 16 * (i_ >> 1) + 4 * hh); }     \
                    else f_[i_] = lds_frag32(lds + DP_KDT + (32 * i_ + r) * R64 + 64 * (((g_) - 10) >> 1), 16 * (((g_) - 10) & 1) + 4 * hh); } } while (0)
            LOAD_GROUP(0, fb[0]);
            if (DELTA) {
#pragma unroll
                for (int mt = 0; mt < 2; ++mt)
#pragma unroll
                    for (int g = 0; g < 4; ++g) { const u32x2 u = *(const LAS u32x2*)(lds + DP_UT + (dv0 + r) * R64 + (32 * mt + 8 * g + 4 * hh) * 2);
                        V[mt][4 * g + 0] = bflo(u.x); V[mt][4 * g + 1] = bfhi(u.x); V[mt][4 * g + 2] = bflo(u.y); V[mt][4 * g + 3] = bfhi(u.y); }
            }
            float gl = 1.f; if (DELTA) gl = *(const LAS float*)(lds + DP_GL);
#pragma unroll
            for (int g = 0; g < NG; ++g) {
                if (g + 1 < NG) LOAD_GROUP(g + 1, fb[(g + 1) & 1]);
                __builtin_amdgcn_sched_barrier(0);
                if (g == 8) {
#pragma unroll
                    for (int mt = 0; mt < 2; ++mt)
#pragma unroll
                        for (int s = 0; s < 2; ++s) Vpk[mt][s] = pack_acc(V[mt], s);
                }
                if (g == 10) {
#pragma unroll
                    for (int a = 0; a < 4; ++a)
#pragma unroll
                        for (int i = 0; i < 16; ++i) S[a][i] *= gl;
                }
#pragma unroll
                for (int i = 0; i < 4; ++i) {
                    if (g < 4) O[i & 1] = MFMA32(fb[g & 1][i], Spk[g][i >> 1], O[i & 1]);
                    else if (g < 8) V[i & 1] = MFMA32(fb[g & 1][i], Spk[g - 4][i >> 1], V[i & 1]);
                    else if (g < 10) { if (g == 8 || (i & 1)) O[i & 1] = MFMA32(fb[g & 1][i], Vpk[g - 8][i >> 1], O[i & 1]); }
                    else S[i] = MFMA32(fb[g & 1][i], Vpk[(g - 10) >> 1][(g - 10) & 1], S[i]);
                }
                __builtin_amdgcn_sched_barrier(0);
            }
#undef LOAD_GROUP
            if (!DELTA) {
#pragma unroll
                for (int a = 0; a < 4; ++a)
#pragma unroll
                    for (int g = 0; g < 4; ++g) { const f32x4 d4 = *(const LAS f32x4*)(dvec + 32 * a + 8 * g + 4 * hh);
#pragma unroll
                        for (int e = 0; e < 4; ++e) { const int i = 4 * g + e; const unsigned w = *(const LAS unsigned*)(lds + SS_BLOC + (((wave * 4 + a) * 8 + (i >> 1)) * 64 + lane) * 4); S[a][i] = d4[e] * S[a][i] + ((i & 1) ? bfhi(w) : bflo(w)); } }
            }
#pragma unroll
            for (int mt = 0; mt < 2; ++mt)
#pragma unroll
                for (int i = 0; i < 16; ++i) obuf[(c & 1) * (SS_OBUF_SZ / 4) + (32 * mt + (i & 3) + 8 * (i >> 2) + 4 * hh) * 132 + dv0 + r] = O[mt][i];
            BAR_LDS();
        }
        float* so = P.out + (DELTA ? OUT_DP : OUT_HP) + ((size_t)(l * NB + b) * NH + h) * DH * DH;
#pragma unroll
        for (int a = 0; a < 4; ++a)
#pragma unroll
            for (int i = 0; i < 16; ++i) so[(size_t)(32 * a + (i & 3) + 8 * (i >> 2) + 4 * hh) * DH + dv0 + r] = S[a][i];
    } else {
        const int tl0 = tid - 256, lane0 = lane;
        u32x4 stgA[DELTA ? 19 : 12]; float dnA = 0.f;
#define LD_IMG(cc_, stg_, dn_) do { int tl = tl0; asm volatile("" : "+v"(tl)); \
            if (DELTA) { const unsigned char* pack = ws + WS_DPACK + (size_t)(bh * NCH + (cc_)) * DPACK_STRIDE; \
                _Pragma("unroll") for (int i = 0; i < 19; ++i) { const int e = tl + 256 * i; if (i < 18 || e < DP_BYTES / 16) stg_[i] = *(const u32x4*)(pack + e * 16); } \
            } else { const unsigned char* hp = ws + WS_HPACK + (size_t)(bh * NCH + (cc_)) * HPACK_STRIDE; const int R1 = b * SEQ + (cc_) * CH; \
                _Pragma("unroll") for (int i = 0; i < 4; ++i) { const int e = tl + 256 * i; stg_[i] = *(const u32x4*)(PROJ + (size_t)(R1 + (e >> 4)) * NIN + PC_QB + h * DH + (e & 15) * 8); } \
                _Pragma("unroll") for (int i = 0; i < 8; ++i) stg_[4 + i] = *(const u32x4*)(hp + (tl + 256 * i) * 16); \
                if (tl < 128) dn_ = *(const float*)(hp + 32768 + 4 * tl); } } while (0)
#define ST_IMG(stg_, dn_) do { int tl = tl0; asm volatile("" : "+v"(tl)); \
            if (DELTA) { _Pragma("unroll") for (int i = 0; i < 19; ++i) { const int e = tl + 256 * i; if (i < 18 || e < DP_BYTES / 16) *(LAS u32x4*)(lds + e * 16) = stg_[i]; } \
            } else { _Pragma("unroll") for (int i = 0; i < 4; ++i) { const int e = tl + 256 * i; LAS unsigned char* d = lds + DP_QD + (e >> 4) * R128 + (e & 15) * 16; \
                    *(LAS u32x2*)d = (u32x2){stg_[i].x, stg_[i].y}; *(LAS u32x2*)(d + 8) = (u32x2){stg_[i].z, stg_[i].w}; } \
                _Pragma("unroll") for (int i = 0; i < 8; ++i) *(LAS u32x4*)(lds + SS_BLOC + (tl + 256 * i) * 16) = stg_[4 + i]; \
                if (tl < 128) dvec[tl] = dn_; } } while (0)
        u32x4 gzE[4], gzO[4], olE[4], olO[4];
        float nwv[16];
#pragma unroll
        for (int q = 0; q < 16; ++q) nwv[q] = normw[16 * (lane0 & 7) + q];
        for (int c = 0; c < NCH; c += 2) {
            BAR_LDS();
            SCAN_PREFETCH(c, gzE, olE);
            LD_IMG(c + 1, stgA, dnA);
            if (c > 0) SCAN_FINISH(c - 1, gzO, olO);
            BAR_LDS();
            ST_IMG(stgA, dnA);
            BAR_LDS();
            SCAN_PREFETCH(c + 1, gzO, olO);
            if (c + 2 < NCH) LD_IMG(c + 2, stgA, dnA);
            SCAN_FINISH(c, gzE, olE);
            BAR_LDS();
            if (c + 2 < NCH) ST_IMG(stgA, dnA);
        }
        SCAN_FINISH(NCH - 1, gzO, olO);
#undef LD_IMG
#undef ST_IMG
    }
#undef SCAN_FINISH
#undef SCAN_PREFETCH
    __syncthreads();
}

DI void sample_item(const Params& P, int l, int s, int h, LAS unsigned char* lds) {
    int tid_ = threadIdx.x; asm volatile("" : "+v"(tid_));
    const int tid = tid_, lane = tid & 63, wave = tid >> 6;
    unsigned char* ws = P.ws;
    const bf16_t* PROJ = (const bf16_t*)(ws + WS_PROJ);
    bf16_t* MIX = (bf16_t*)(ws + WS_H);
    const float* AB = (const float*)(ws + WS_AB);
    const int row = MP + s;
    LAS float* cv = (LAS float*)lds;
    LAS float* sc = (LAS float*)(lds + 2048);
    LAS float* part = (LAS float*)(lds + 4096);
    LAS float* fq_ = (LAS float*)(lds + 4096 + 8192);
    __syncthreads();
    if (tid < 384) {
        const int m = tid >> 7, ch = tid & 127, chan = m * 512 + h * DH + ch;
        const float* sb = P.state_conv + ((size_t)(l * MS + s) * 3) * CONVD + chan;
        const float b0 = sb[0], b1 = sb[CONVD], b2 = sb[2 * CONVD];
        const float xn = bf2f(PROJ[(size_t)row * NIN + chan]);
        const float* cw = P.conv_w + (size_t)l * 4 * CONVD + chan;
        const float y = siluf_(cw[0] * b0 + cw[CONVD] * b1 + cw[2 * CONVD] * b2 + cw[3 * CONVD] * xn);
        float* co = P.out + OUT_CS + ((size_t)(l * MS + s) * 3) * CONVD + chan;
        co[0] = b1; co[CONVD] = b2; co[2 * CONVD] = xn;
        cv[m * 128 + ch] = y;
    } else {
        const int dk = tid - 384;
        const float lbv = ((const float*)(ws + WS_LB))[l * 512 + h * DH + dk];
        const float fb = bf2f(PROJ[(size_t)row * NIN + PC_FB + h * DH + dk]), qb = bf2f(PROJ[(size_t)row * NIN + PC_QB + h * DH + dk]);
        fq_[dk] = lbv + (1.f - lbv) * sigmoidf_(fb); fq_[128 + dk] = siluf_(qb);
    }
    __syncthreads();
    if (wave < 2) { const f32x2 v = *(const LAS f32x2*)(cv + wave * 128 + 2 * lane); const float ss = wave_sum(v.x * v.x + v.y * v.y); if (lane == 0) sc[wave] = ss; }
    __syncthreads();
    const float rq = rsqrtf(sc[0] + EPS) * 0.08838834764831845f, rk = rsqrtf(sc[1] + EPS);
    const float aa = AB[(size_t)row * 8 + h], ba = AB[(size_t)row * 8 + 4 + h];
    const float xx = aa + P.dt_bias[l * NH + h];
    const float sp = xx > 20.f ? xx : log1pf(expf(xx));
    const float eg = expf(-expf(P.a_log[l * NH + h]) * sp);
    const float beta = 1.f / (1.f + expf(-ba));
    const int dvq = tid & 31, dkg = tid >> 5;
    const size_t sbase = ((size_t)(l * MS + s) * NH + h) * DH * DH;
    {
        const float* Sin = P.state_delta + sbase; float* Sout = P.out + OUT_DS + sbase;
        f32x4 St[8]; f32x4 kv = {0.f, 0.f, 0.f, 0.f};
#pragma unroll
        for (int i = 0; i < 8; ++i) { const int dk = dkg + 16 * i; St[i] = *(const f32x4*)(Sin + (size_t)dk * DH + 4 * dvq) * eg; kv += St[i] * (cv[128 + dk] * rk); }
        *(LAS f32x4*)(part + dkg * 128 + 4 * dvq) = kv;
        __syncthreads();
        f32x4 kvs = {0.f, 0.f, 0.f, 0.f};
#pragma unroll
        for (int j = 0; j < 16; ++j) kvs += *(const LAS f32x4*)(part + j * 128 + 4 * dvq);
        const f32x4 v4 = *(const LAS f32x4*)(cv + 256 + 4 * dvq);
        const f32x4 vnew = (v4 - kvs) * beta;
        f32x4 op = {0.f, 0.f, 0.f, 0.f};
        __syncthreads();
#pragma unroll
        for (int i = 0; i < 8; ++i) { const int dk = dkg + 16 * i; St[i] += vnew * (cv[128 + dk] * rk); *(f32x4*)(Sout + (size_t)dk * DH + 4 * dvq) = St[i]; op += St[i] * (cv[dk] * rq); }
        *(LAS f32x4*)(part + dkg * 128 + 4 * dvq) = op;
        __syncthreads();
        if (tid < 32) {
            f32x4 o = {0.f, 0.f, 0.f, 0.f};
#pragma unroll
            for (int j = 0; j < 16; ++j) o += *(const LAS f32x4*)(part + j * 128 + 4 * tid);
            float ss = o.x * o.x + o.y * o.y + o.z * o.z + o.w * o.w;
#pragma unroll
            for (int m = 1; m < 32; m <<= 1) ss += __shfl_xor(ss, m);
            const float rs = rsqrtf(ss * (1.f / DH) + EPS);
            const f32x4 nw = *(const f32x4*)(P.norm_a + l * DH + 4 * tid);
            const u32x2 zz = *(const u32x2*)(PROJ + (size_t)row * NIN + PC_ZA + h * DH + 4 * tid);
            u32x2 w; w.x = pk2(o.x * rs * nw.x * bflo(zz.x), o.y * rs * nw.y * bfhi(zz.x)); w.y = pk2(o.z * rs * nw.z * bflo(zz.y), o.w * rs * nw.w * bfhi(zz.y));
            *(u32x2*)(MIX + (size_t)row * DM + h * DH + 4 * tid) = w;
        }
        __syncthreads();
    }
    {
        const float* Sin = P.state_hgrn + sbase; float* Sout = P.out + OUT_HS + sbase;
        const u32x2 ib = *(const u32x2*)(PROJ + (size_t)row * NIN + PC_IB + h * DH + 4 * dvq);
        const f32x4 v4 = {bflo(ib.x), bfhi(ib.x), bflo(ib.y), bfhi(ib.y)};
        f32x4 op = {0.f, 0.f, 0.f, 0.f};
#pragma unroll
        for (int i = 0; i < 8; ++i) { const int dk = dkg + 16 * i; const float f = fq_[dk];
            const f32x4 sn = *(const f32x4*)(Sin + (size_t)dk * DH + 4 * dvq) * f + v4 * (1.f - f);
            *(f32x4*)(Sout + (size_t)dk * DH + 4 * dvq) = sn; op += sn * fq_[128 + dk]; }
        *(LAS f32x4*)(part + dkg * 128 + 4 * dvq) = op;
        __syncthreads();
        if (tid < 32) {
            f32x4 o = {0.f, 0.f, 0.f, 0.f};
#pragma unroll
            for (int j = 0; j < 16; ++j) o += *(const LAS f32x4*)(part + j * 128 + 4 * tid);
            float ss = o.x * o.x + o.y * o.y + o.z * o.z + o.w * o.w;
#pragma unroll
            for (int m = 1; m < 32; m <<= 1) ss += __shfl_xor(ss, m);
            const float rs = rsqrtf(ss * (1.f / DH) + EPS);
            const f32x4 nw = *(const f32x4*)(P.norm_b + l * DH + 4 * tid);
            const u32x2 zz = *(const u32x2*)(PROJ + (size_t)row * NIN + PC_OB + h * DH + 4 * tid);
            u32x2 w; w.x = pk2(o.x * rs * nw.x * bflo(zz.x), o.y * rs * nw.y * bfhi(zz.x)); w.y = pk2(o.z * rs * nw.z * bflo(zz.y), o.w * rs * nw.w * bfhi(zz.y));
            *(u32x2*)(MIX + (size_t)row * DM + 512 + h * DH + 4 * tid) = w;
        }
        __syncthreads();
    }
}

DI void phase_scan(const Params& P, int l, LAS unsigned char* lds) {
    const int G = gridDim.x, bid = blockIdx.x;
    const int step = (G > 64) ? (bid < 64 ? (1 << 30) : G - 64) : G;
    for (int j = bid; j < 64 + MS * NH; j += step) {
        if (j < 32) { scan_prompt<true>(P, l, j, lds);
#ifdef REP_SD
            scan_prompt<true>(P, l, j, lds);
#endif
        }
        else if (j < 64) scan_prompt<false>(P, l, j - 32, lds);
        else { sample_item(P, l, (j - 64) >> 2, (j - 64) & 3, lds);
#ifdef REP_SS
            sample_item(P, l, (j - 64) >> 2, (j - 64) & 3, lds);
#endif
        }
    }
    if (l == 0) { if (G > 64) { if (bid >= 64) phase0_rest(P, lds, bid - 64, G - 64); } else phase0_rest(P, lds, bid, G); }
}
DI bf16x8 gl_frag16(const bf16_t* p) { return *(const bf16x8*)p; }
template <int KIND, int KS, bool IN_F32 = false>
DI void sgemm_phase(const Params& P, int l, const bf16_t* A, const bf16_t* Bt, int N  , const void* xin_s, const float* gate, LAS unsigned char* lds, int first_blk = 0, bf16_t* xout_s = nullptr) {
    int tid_ = threadIdx.x; asm volatile("" : "+v"(tid_));
    const int tid = tid_, lane = tid & 63, wave = tid >> 6, fr = lane & 15, fq = lane >> 4;
    constexpr int NC = KIND == 0 ? 4 : 2, NACC = KIND == 1 ? 2 : 4, K = 256 * KS;
    const int ncg = N / (16 * NC), nunits = 8 * ncg;
    unsigned char* ws = P.ws;
    LAS f32x4* red = (LAS f32x4*)lds;
    if ((int)blockIdx.x < first_blk) return;
    for (int unit = blockIdx.x - first_blk; unit < nunits; unit += gridDim.x - first_blk) {
        const int rt = unit % 8, cg = unit / 8, n0 = cg * 16 * NC;
        f32x4 acc[NACC];
#pragma unroll
        for (int i = 0; i < NACC; ++i) acc[i] = (f32x4){0.f, 0.f, 0.f, 0.f};
        const bf16_t* ap = A + (size_t)(16 * rt + fr) * K + wave * (32 * KS) + 8 * fq;
        const bf16_t* bp[NC];
#pragma unroll
        for (int ct = 0; ct < NC; ++ct) { const int c = n0 + 16 * ct + fr; const int brow = KIND == 2 ? 256 * (c >> 7) + (c & 127) : c; bp[ct] = Bt + (size_t)brow * K + wave * (32 * KS) + 8 * fq; }
#pragma unroll
        for (int ks = 0; ks < KS; ++ks) {
            const bf16x8 a = gl_frag16(ap + 32 * ks);
#pragma unroll
            for (int ct = 0; ct < NC; ++ct) {
                acc[ct] = MFMA16(gl_frag16(bp[ct] + 32 * ks), a, acc[ct]);
                if (KIND == 2) acc[2 + ct] = MFMA16(gl_frag16(bp[ct] + (size_t)128 * K + 32 * ks), a, acc[2 + ct]);
            }
        }
#pragma unroll
        for (int i = 0; i < NACC; ++i) red[(wave * NACC + i) * 64 + lane] = acc[i];
        __syncthreads();
        if (wave < NC) {
            const int ct = wave;
            f32x4 s0 = (f32x4){0.f, 0.f, 0.f, 0.f}, s1 = (f32x4){0.f, 0.f, 0.f, 0.f};
#pragma unroll
            for (int w = 0; w < 8; ++w) { s0 += red[(w * NACC + ct) * 64 + lane]; if (KIND == 2) s1 += red[(w * NACC + 2 + ct) * 64 + lane]; }
            const int m = 16 * rt + fr, row = MP + m, col = n0 + 16 * ct + 4 * fq;
            if (KIND == 0) { const int tile = col >> 8; if (tile == 6 || tile == 7) { for (int j = 0; j < 4; ++j) s0[j] = siluf_(s0[j]); } else if (tile >= 14) { for (int j = 0; j < 4; ++j) s0[j] = sigmoidf_(s0[j]); }
                u32x2 o; o.x = pk2(s0[0], s0[1]); o.y = pk2(s0[2], s0[3]); *(u32x2*)((bf16_t*)(ws + WS_PROJ) + (size_t)row * NIN + col) = o; }
            else if (KIND == 1) { f32x4 xv; if (IN_F32) xv = *(const f32x4*)((const float*)xin_s + (size_t)m * DM + col); else { const u32x2 w = *(const u32x2*)((const bf16_t*)xin_s + (size_t)m * DM + col); xv = (f32x4){bflo(w.x), bfhi(w.x), bflo(w.y), bfhi(w.y)}; }
                const f32x4 gv = *(const f32x4*)(gate + (size_t)(NB + m) * NMOD + col); const f32x4 r = xv + gv * s0;
                u32x2 o; o.x = pk2(r.x, r.y); o.y = pk2(r.z, r.w); *(u32x2*)((xout_s ? xout_s : (bf16_t*)P.out + (size_t)MP * DM) + (size_t)m * DM + col) = o; }
            else { float r[4];
#pragma unroll
                for (int j = 0; j < 4; ++j) r[j] = siluf_(s0[j]) * s1[j];
                u32x2 o; o.x = pk2(r[0], r[1]); o.y = pk2(r[2], r[3]); *(u32x2*)((bf16_t*)(ws + WS_PROJ) + (size_t)row * DFF + col) = o; }
        }
        __syncthreads();
    }
}
#ifndef GEMM_SP2
#define GEMM_SP2 true
#endif
#ifndef GEMM_ALIGN
#define GEMM_ALIGN true
#endif
constexpr int NPHASE = 18;
#ifndef N_LAUNCH_MODE
#define N_LAUNCH_MODE 1
#endif

DI void run_phase(const Params& P, int ph, LAS unsigned char* lds) {
    unsigned char* ws = P.ws;
    const int G = gridDim.x;
    {
        if (ph == 0) phase0(P, lds);
        else {
            const int l = (ph - 1) >> 3, k = (ph - 1) & 7;
            bf16_t* H = (bf16_t*)(ws + WS_H);
            bf16_t* PROJ = (bf16_t*)(ws + WS_PROJ);
            const float* mods = (const float*)(ws + WS_MODS) + (size_t)l * MODROWS * NMOD;
            bf16_t* XB = (bf16_t*)P.out;
            if (k == 0) { if (l == 0) phase_norm<1>(P, 0, lds); else phase_norm<1>(P, 1, lds); }
            else if (k == 1) {
                pg8::Gemm g{H, (const bf16_t*)(ws + WS_WIN + l * SZ_WIN), MP, NIN, DM}; pg8::StaticOrder S; S.init(MP, NIN, G, (int)blockIdx.x);
                pg8::EpiProj E{PROJ, NIN};
                pg8::gemm_phase<pg8::EpiProj, pg8::StaticOrder, GEMM_ALIGN, GEMM_SP2>(lds, g, S, E);
                sgemm_phase<0, 4>(P, l, H + (size_t)MP * DM, (const bf16_t*)(ws + WS_WIN + l * SZ_WIN), NIN, nullptr, nullptr, lds);
            }
            else if (k == 2) phase_chunks(P, l, lds);
            else if (k == 3) phase_scan(P, l, lds);
            else if (k == 4) {
                pg8::Gemm g{H, (const bf16_t*)(ws + WS_WOUT + l * SZ_WOUT), MP, DM, DM}; pg8::StaticOrder S; S.init(MP, DM, G, (int)blockIdx.x);
                if (l == 0) { pg8::EpiRes<true> E{P.x_prompt, XB, mods + 2 * DM}; pg8::gemm_phase<pg8::EpiRes<true>, pg8::StaticOrder, GEMM_ALIGN, GEMM_SP2>(lds, g, S, E);
                    sgemm_phase<1, 4, true>(P, l, H + (size_t)MP * DM, (const bf16_t*)(ws + WS_WOUT + l * SZ_WOUT), DM, P.x_sample, mods + 2 * DM, lds); }
                else { pg8::EpiRes<false> E{XB, XB, mods + 2 * DM}; pg8::gemm_phase<pg8::EpiRes<false>, pg8::StaticOrder, GEMM_ALIGN, GEMM_SP2>(lds, g, S, E);
                    sgemm_phase<1, 4, false>(P, l, H + (size_t)MP * DM, (const bf16_t*)(ws + WS_WOUT + l * SZ_WOUT), DM, XB + (size_t)MP * DM, mods + 2 * DM, lds); }
            }
            else if (k == 5) phase_norm<2>(P, l, lds);
            else if (k == 6) {
                pg8::Gemm g{H, (const bf16_t*)(ws + WS_WGU + l * SZ_WGU), MP, NGU, DM}; pg8::StaticOrder S; S.init(MP, NGU, G, (int)blockIdx.x);
                pg8::EpiSwiGLU E{PROJ, DFF};
                pg8::gemm_phase<pg8::EpiSwiGLU, pg8::StaticOrder, GEMM_ALIGN, GEMM_SP2>(lds, g, S, E);
                sgemm_phase<2, 4>(P, l, H + (size_t)MP * DM, (const bf16_t*)(ws + WS_WGU + l * SZ_WGU), DFF, nullptr, nullptr, lds, ((MP / 256) * (NGU / 256)) % G);
            }
            else {
                pg8::Gemm g{PROJ, (const bf16_t*)(ws + WS_WDN + l * SZ_WDN), MP, DM, DFF}; pg8::StaticOrder S; S.init(MP, DM, G, (int)blockIdx.x);
                bf16_t* XO = (l == 1) ? H : XB;
                pg8::EpiRes<false> E{XB, XO, mods + 5 * DM};
                pg8::gemm_phase<pg8::EpiRes<false>, pg8::StaticOrder, GEMM_ALIGN, GEMM_SP2>(lds, g, S, E);
                sgemm_phase<1, 11, false>(P, l, PROJ + (size_t)MP * DFF, (const bf16_t*)(ws + WS_WDN + l * SZ_WDN), DM, XB + (size_t)MP * DM, mods + 5 * DM, lds, 0, XO + (size_t)MP * DM);
            }
        }
    }
}

__global__ void __launch_bounds__(512, 2) fwd_kernel(Params P) {
    extern __shared__ __attribute__((aligned(16))) unsigned char lds_raw[];
    LAS unsigned char* lds = (LAS unsigned char*)lds_raw;
    cg::grid_group grid = cg::this_grid();
    unsigned char* ws = P.ws;
    XcdBarrier bar; bar.bar = (unsigned*)(ws + WS_BAR); bar.x = 0; bar.st = nullptr;
    if (P.ph_hi - P.ph_lo > 1) {
        volatile LAS unsigned* st = (volatile LAS unsigned*)(lds + LDS_MISC);
        if (threadIdx.x < 2) st[threadIdx.x] = 0u;
        __syncthreads();
        bar = xcd_barrier_post((unsigned*)(ws + WS_BAR), st);
    }
    for (int ph = P.ph_lo; ph < P.ph_hi; ++ph) {
        Params Q = P;
        size_t z0 = 0; asm volatile("" : "+s"(z0)); Q.ws = P.ws + z0; Q.out = P.out + z0;
        if (ph == NPHASE - 1) phase_final(Q); else run_phase(Q, ph, lds);
#ifdef REP_MASK
        if ((REP_MASK >> ph) & 1) run_phase(Q, ph, lds);
#endif
#ifdef REP_BAR
        if (ph + 1 < P.ph_hi && ph > 0) { xcd_barrier(bar); }
#endif
        if (ph + 1 < P.ph_hi) { if (P.ph_lo < 0) { __threadfence(); grid.sync(); } else xcd_barrier(bar); }
    }
}

extern "C" void kernel_launch(void* const* d_in, const int* in_sizes, int n_in, void* d_out, int out_size, void* d_ws, size_t ws_size, hipStream_t stream) {
    static int grid = 0;
    if (grid == 0) {
        if (n_in != 23 || (size_t)out_size != OUT_END || ws_size < WS_END) { grid = -1; }
        else {
            int dev = 0, cus = 0, per_cu = 0;
            if (hipGetDevice(&dev) != hipSuccess || hipDeviceGetAttribute(&cus, hipDeviceAttributeMultiprocessorCount, dev) != hipSuccess) grid = -1;
            else if (hipFuncSetAttribute((const void*)fwd_kernel, hipFuncAttributeMaxDynamicSharedMemorySize, LDS_BYTES) != hipSuccess) grid = -1;
            else if (hipOccupancyMaxActiveBlocksPerMultiprocessor(&per_cu, (const void*)fwd_kernel, 512, LDS_BYTES) != hipSuccess || per_cu < 1) grid = -1;
            else grid = cus;
        }
    }
    if (grid < 0) { (void)hipMemsetAsync(d_out, 0xFF, (size_t)out_size * 4, stream); return; }
    (void)hipMemsetAsync((unsigned char*)d_ws + WS_BAR, 0, 16384, stream);
    Params p{};
    p.x_prompt = (const float*)d_in[0]; p.x_sample = (const float*)d_in[1]; p.c_prompt = (const float*)d_in[2]; p.c_sample = (const float*)d_in[3];
    p.state_delta = (const float*)d_in[4]; p.state_conv = (const float*)d_in[5]; p.state_hgrn = (const float*)d_in[6];
    p.w_ada = (const float*)d_in[7]; p.b_ada = (const float*)d_in[8]; p.norm1 = (const float*)d_in[9]; p.w_in = (const float*)d_in[10];
    p.conv_w = (const float*)d_in[11]; p.a_log = (const float*)d_in[12]; p.dt_bias = (const float*)d_in[13]; p.norm_a = (const float*)d_in[14];
    p.norm_b = (const float*)d_in[15]; p.lb_logits = (const float*)d_in[16]; p.w_out = (const float*)d_in[17]; p.norm2 = (const float*)d_in[18];
    p.w_gate = (const float*)d_in[19]; p.w_up = (const float*)d_in[20]; p.w_down = (const float*)d_in[21]; p.norm_f = (const float*)d_in[22];
    p.out = (float*)d_out; p.ws = (unsigned char*)d_ws;
#if N_LAUNCH_MODE == 1
    p.ph_lo = 0; p.ph_hi = NPHASE;
    void* args[] = {&p};
    (void)hipLaunchCooperativeKernel((const void*)fwd_kernel, dim3(grid), dim3(512), args, LDS_BYTES, stream);
#else
    for (int ph = 0; ph < NPHASE; ++ph) { p.ph_lo = ph; p.ph_hi = ph + 1; hipLaunchKernelGGL(fwd_kernel, dim3(grid), dim3(512), LDS_BYTES, stream, p); }
#endif
}
```
